# Optimizing an MI355X kernel written in HIP

```python
import math
import jax, jax.numpy as jnp
from jax import lax
import numpy as np

D_MODEL = 1024
BATCH = 4
SEQ = 4096
DEPTH = 1

MEM_LEN = 256
HEAD_DIM = 64
N_ATTN_HEADS = 8
ATTN_WIDTH = N_ATTN_HEADS * HEAD_DIM
CONV_WIDTH = D_MODEL - ATTN_WIDTH
N_CONV_GROUPS = CONV_WIDTH // HEAD_DIM
MIX_WIDTH = ATTN_WIDTH + CONV_WIDTH
IN_PROJ_COLS = 3 * ATTN_WIDTH + 3 * CONV_WIDTH
DILATED_PATTERNS = ((128, 1), (512, 4), (2048, 16))
SEQ_PAD_MULT = max(w for w, _ in DILATED_PATTERNS)
N_BUCKETS = 32
BUCKET_MAX_EXACT = N_BUCKETS // 2
BUCKET_MAX_DISTANCE = 2048
SHORT_CONV_K = 3
FFN_CONV_K = 3
D_FF = 2816
N_MEM_HEADS = 4
MEM_HEAD_DIM = D_MODEL // N_MEM_HEADS
EPS = 1e-6

kernel_name = "hymba_dilated_shortconv_convffn_memxattn"


def rms_norm(x, g):
    xf = x.astype(jnp.float32)
    y = xf * lax.rsqrt(jnp.mean(xf * xf, axis=-1, keepdims=True) + EPS)
    return (y * g.astype(jnp.float32)).astype(x.dtype)


def causal_dwconv(u, w):
    k_width = w.shape[0]
    s = u.shape[1]
    up = jnp.pad(u, ((0, 0), (k_width - 1, 0), (0, 0)))
    out = up[:, 0:s, :] * w[0]
    for k in range(1, k_width):
        out = out + up[:, k:k + s, :] * w[k]
    return out


def t5_bucket(distance):
    d = jnp.maximum(distance, 1).astype(jnp.float32)
    large = BUCKET_MAX_EXACT + (
        jnp.log(d / BUCKET_MAX_EXACT) / math.log(BUCKET_MAX_DISTANCE / BUCKET_MAX_EXACT)
        * (N_BUCKETS - BUCKET_MAX_EXACT)).astype(jnp.int32)
    large = jnp.minimum(large, N_BUCKETS - 1)
    return jnp.where(distance < BUCKET_MAX_EXACT, distance, large)


def dilated_window_attention(q, k, v, rel_bias, window, dilation):
    b, h, sp, dh = q.shape
    w = window // dilation
    n_sub = sp // dilation
    nb = n_sub // w

    def to_blocks(t):
        t = t.reshape(b, h, n_sub, dilation, -1).transpose(0, 1, 3, 2, 4)
        return t.reshape(b, h, dilation, nb, w, t.shape[-1])

    def from_blocks(t):
        t = t.reshape(b, h, dilation, n_sub, -1).transpose(0, 1, 3, 2, 4)
        return t.reshape(b, h, sp, t.shape[-1])

    def with_prev(t):
        prev = jnp.pad(t, ((0, 0), (0, 0), (0, 0), (1, 0), (0, 0), (0, 0)))[:, :, :, :-1]
        return jnp.concatenate([prev, t], axis=4)

    qb = to_blocks(q)
    kk = with_prev(to_blocks(k))
    vv = with_prev(to_blocks(v))

    logits = jnp.einsum('bhrnid,bhrnjd->bhrnij', qb, kk).astype(jnp.float32)
    qi = jnp.arange(w)[:, None]
    kj = jnp.arange(2 * w)[None, :]
    steps = qi + w - kj
    valid_local = (steps >= 0) & (steps <= w)
    block_idx = jnp.arange(nb)[:, None, None]
    valid = valid_local[None] & ((block_idx > 0) | (kj >= w)[None])
    bucket = t5_bucket(jnp.clip(steps, 0, w) * dilation)
    bias = rel_bias.astype(jnp.float32)[:, bucket]
    logits = logits + bias[None, :, None, None]
    logits = jnp.where(valid, logits, -jnp.inf)
    m = jnp.max(logits, axis=-1, keepdims=True)
    p = jnp.exp(logits - m)
    s = jnp.sum(p, axis=-1, keepdims=True)
    o = jnp.einsum('bhrnij,bhrnjd->bhrnid', p, vv.astype(jnp.float32)) / s
    return from_blocks(o), from_blocks(m), from_blocks(s)


def hybrid_mixer(h, rel_bias, w_in, w_short_conv, g_attn_out, g_conv_out, w_out):
    b, s, _ = h.shape
    proj = h @ w_in
    q, k, v, gate_b, gate_c, x_in = jnp.split(
        proj, [ATTN_WIDTH, 2 * ATTN_WIDTH, 3 * ATTN_WIDTH,
               3 * ATTN_WIDTH + CONV_WIDTH, 3 * ATTN_WIDTH + 2 * CONV_WIDTH], axis=-1)

    sp = ((s + SEQ_PAD_MULT - 1) // SEQ_PAD_MULT) * SEQ_PAD_MULT

    def heads(t):
        t = t.reshape(b, s, N_ATTN_HEADS, HEAD_DIM).transpose(0, 2, 1, 3)
        return jnp.pad(t, ((0, 0), (0, 0), (0, sp - s), (0, 0)))

    qh = heads(q) * (HEAD_DIM ** -0.5)
    kh, vh = heads(k), heads(v)
    branches = [dilated_window_attention(qh, kh, vh, rel_bias, w, d) for (w, d) in DILATED_PATTERNS]
    m_all = branches[0][1]
    for _, m_i, _ in branches[1:]:
        m_all = jnp.maximum(m_all, m_i)
    num = jnp.zeros_like(branches[0][0])
    den = jnp.zeros_like(m_all)
    for o_i, m_i, s_i in branches:
        wt = s_i * jnp.exp(m_i - m_all)
        num = num + wt * o_i
        den = den + wt
    attn = (num / den)[:, :, :s].transpose(0, 2, 1, 3).reshape(b, s, ATTN_WIDTH).astype(h.dtype)

    conv = gate_b * causal_dwconv(gate_c * x_in, w_short_conv)

    mixed = jnp.concatenate([rms_norm(attn, g_attn_out), rms_norm(conv, g_conv_out)], axis=-1)
    return mixed @ w_out


def memory_cross_attention(h, mem_n, w_xq, w_xk, w_xv, w_xo):
    b, s, _ = h.shape
    q = (h @ w_xq).reshape(b, s, N_MEM_HEADS, MEM_HEAD_DIM)
    k = (mem_n @ w_xk).reshape(b, MEM_LEN, N_MEM_HEADS, MEM_HEAD_DIM)
    v = (mem_n @ w_xv).reshape(b, MEM_LEN, N_MEM_HEADS, MEM_HEAD_DIM)
    logits = jnp.einsum('bshd,bmhd->bhsm', q, k).astype(jnp.float32) * (MEM_HEAD_DIM ** -0.5)
    p = jax.nn.softmax(logits, axis=-1)
    o = jnp.einsum('bhsm,bmhd->bshd', p, v.astype(jnp.float32)).astype(h.dtype)
    return o.reshape(b, s, D_MODEL) @ w_xo


def conv_ffn(h, w_up, w_ffn_conv, b_ffn_conv, w_down):
    up = causal_dwconv(h @ w_up, w_ffn_conv) + b_ffn_conv
    gate, val = jnp.split(up, 2, axis=-1)
    return (jax.nn.silu(gate) * val) @ w_down


def setup_inputs(seed: int = 0) -> dict:
    key = jax.random.key(seed)
    ks = iter(jax.random.split(key, 32))
    f32 = jnp.float32
    L = DEPTH

    def dense(shape, fan_in):
        return jax.random.normal(next(ks), shape, f32) * fan_in ** -0.5

    def gain(shape):
        return 1.0 + 0.02 * jax.random.normal(next(ks), shape, f32)

    return {
        "x": jax.random.normal(next(ks), (BATCH, SEQ, D_MODEL), f32),
        "mem": jax.random.normal(next(ks), (BATCH, MEM_LEN, D_MODEL), f32),
        "rel_bias": 0.2 * jax.random.normal(next(ks), (N_ATTN_HEADS, N_BUCKETS), f32),
        "g_mix": gain((L, D_MODEL)),
        "w_in": dense((L, D_MODEL, IN_PROJ_COLS), D_MODEL),
        "w_short_conv": dense((L, SHORT_CONV_K, CONV_WIDTH), SHORT_CONV_K),
        "g_attn_out": gain((L, ATTN_WIDTH)),
        "g_conv_out": gain((L, CONV_WIDTH)),
        "w_out": dense((L, MIX_WIDTH, D_MODEL), MIX_WIDTH),
        "g_xattn": gain((L, D_MODEL)),
        "g_mem": gain((L, D_MODEL)),
        "w_xq": dense((L, D_MODEL, D_MODEL), D_MODEL),
        "w_xk": dense((L, D_MODEL, D_MODEL), D_MODEL),
        "w_xv": dense((L, D_MODEL, D_MODEL), D_MODEL),
        "w_xo": dense((L, D_MODEL, D_MODEL), D_MODEL),
        "g_ffn": gain((L, D_MODEL)),
        "w_up": dense((L, D_MODEL, 2 * D_FF), D_MODEL),
        "w_ffn_conv": dense((L, FFN_CONV_K, 2 * D_FF), FFN_CONV_K),
        "b_ffn_conv": 0.02 * jax.random.normal(next(ks), (L, 2 * D_FF), f32),
        "w_down": dense((L, D_FF, D_MODEL), D_FF),
        "g_final": gain((D_MODEL,)),
    }


def reference(x, mem, rel_bias, g_mix, w_in, w_short_conv, g_attn_out, g_conv_out, w_out,
              g_xattn, g_mem, w_xq, w_xk, w_xv, w_xo, g_ffn, w_up, w_ffn_conv, b_ffn_conv,
              w_down, g_final):
    for l in range(DEPTH):
        x = x + hybrid_mixer(rms_norm(x, g_mix[l]), rel_bias, w_in[l], w_short_conv[l],
                             g_attn_out[l], g_conv_out[l], w_out[l])
        x = x + memory_cross_attention(rms_norm(x, g_xattn[l]), rms_norm(mem, g_mem[l]),
                                       w_xq[l], w_xk[l], w_xv[l], w_xo[l])
        x = x + conv_ffn(rms_norm(x, g_ffn[l]), w_up[l], w_ffn_conv[l], b_ffn_conv[l], w_down[l])
    return rms_norm(x, g_final)
```

```cpp
#include <hip/hip_runtime.h>
#include <cstdio>
#include <cstdint>

#define LAS __attribute__((address_space(3)))
typedef unsigned short bf16;
typedef short bf16x8 __attribute__((ext_vector_type(8)));
typedef unsigned short u16x8 __attribute__((ext_vector_type(8)));
typedef unsigned short u16x4 __attribute__((ext_vector_type(4)));
typedef float f32x4 __attribute__((ext_vector_type(4)));
typedef unsigned u32x4 __attribute__((ext_vector_type(4)));

constexpr int NB = 4, SEQ = 4096, DM = 1024, M = NB * SEQ;
constexpr int HD = 64, NH = 8, AW = 512, CW = 512, NPROJ = 3072;
constexpr int DFF = 2816, NUP = 2 * DFF;
constexpr int MEML = 256, XH = 4, XHD = 256, MM = NB * MEML;
constexpr float EPS = 1e-6f;
constexpr float LOG2E = 1.4426950408889634f;
constexpr int NTHR = 512, NWAVES = 8;
constexpr int LDS_BYTES = 147456;

constexpr size_t MiB = 1u << 20;
constexpr size_t WS_XN = 0;
constexpr size_t WS_PROJ = 32 * MiB;
constexpr size_t WS_PART = 128 * MiB;
constexpr size_t WS_STM = 176 * MiB;
constexpr size_t WS_STL = 178 * MiB;
constexpr size_t WS_MIX = 180 * MiB;
constexpr size_t WS_MEMN = 212 * MiB;
constexpr size_t WS_K2 = 214 * MiB;
constexpr size_t WS_V2 = 216 * MiB;
constexpr size_t WS_Q2 = 32 * MiB;
constexpr size_t WS_O2 = 64 * MiB;
constexpr size_t WS_UPH = 32 * MiB;
constexpr size_t WS_ACT = 120 * MiB;

__device__ __forceinline__ float bf2f(bf16 v) { return __uint_as_float(((unsigned)v) << 16); }
__device__ __forceinline__ bf16 f2bf(float f) { unsigned u = __float_as_uint(f); return (bf16)((u + 0x7fffu + ((u >> 16) & 1u)) >> 16); }
__device__ __forceinline__ unsigned pk2(float lo, float hi) { return (unsigned)f2bf(lo) | ((unsigned)f2bf(hi) << 16); }
__device__ __forceinline__ float wave_sum(float v) {
#pragma unroll
    for (int o = 1; o < 64; o <<= 1) v += __shfl_xor(v, o);
    return v;
}
__device__ __forceinline__ float wave_max(float v) {
#pragma unroll
    for (int o = 1; o < 64; o <<= 1) v = fmaxf(v, __shfl_xor(v, o));
    return v;
}

struct Args {
    const float* in[21];
    float* out;
    unsigned char* ws;
    int ph_lo, ph_hi;
};

__device__ __forceinline__ void rms_rows_bf16(const float* src, const float* g, bf16* dst, int nrows, int gw, int ngw, int lane) {
    for (int r = gw; r < nrows; r += ngw) {
        const f32x4* xr = (const f32x4*)(src + (size_t)r * DM) + lane;
        f32x4 v[4]; float s = 0.f;
#pragma unroll
        for (int j = 0; j < 4; ++j) { v[j] = xr[64 * j]; s += v[j].x * v[j].x + v[j].y * v[j].y + v[j].z * v[j].z + v[j].w * v[j].w; }
        const float rstd = rsqrtf(wave_sum(s) * (1.f / DM) + EPS);
        unsigned long long* o8 = (unsigned long long*)(dst + (size_t)r * DM) + lane;
#pragma unroll
        for (int j = 0; j < 4; ++j) { const f32x4 gv = ((const f32x4*)g)[lane + 64 * j];
            o8[64 * j] = (unsigned long long)pk2(v[j].x * rstd * gv.x, v[j].y * rstd * gv.y) | ((unsigned long long)pk2(v[j].z * rstd * gv.z, v[j].w * rstd * gv.w) << 32); }
    }
}
__device__ __forceinline__ void rms_rows_f32_inplace(float* buf, const float* g, int nrows, int gw, int ngw, int lane) {
    for (int r = gw; r < nrows; r += ngw) {
        f32x4* xr = (f32x4*)(buf + (size_t)r * DM) + lane;
        f32x4 v[4]; float s = 0.f;
#pragma unroll
        for (int j = 0; j < 4; ++j) { v[j] = xr[64 * j]; s += v[j].x * v[j].x + v[j].y * v[j].y + v[j].z * v[j].z + v[j].w * v[j].w; }
        const float rstd = rsqrtf(wave_sum(s) * (1.f / DM) + EPS);
#pragma unroll
        for (int j = 0; j < 4; ++j) { const f32x4 gv = ((const f32x4*)g)[lane + 64 * j]; xr[64 * j] = v[j] * rstd * gv; }
    }
}

template <class Epi>
__device__ __forceinline__ void ngemm(const bf16* A, int lda, const float* W, int ldw, int Mrows, int Ncols, int K, unsigned char* lds, const Epi& epi) {
    bf16* sA = (bf16*)lds;
    bf16* sB = (bf16*)(lds + 128 * 40 * 2);
    const int tid = threadIdx.x, lane = tid & 63, wid = tid >> 6, wm = wid >> 1, wn = wid & 1, fr = lane & 15, fq = lane >> 4;
    const int tm = Mrows / 128, tn = Ncols / 128, nt = tm * tn;
    for (int t = blockIdx.x; t < nt; t += gridDim.x) {
        const int pm = t / tn, pn = t % tn;
        f32x4 acc[2][4];
#pragma unroll
        for (int i = 0; i < 2; ++i)
#pragma unroll
            for (int j = 0; j < 4; ++j) acc[i][j] = (f32x4){0.f, 0.f, 0.f, 0.f};
        for (int k0 = 0; k0 < K; k0 += 32) {
            { const int r = tid >> 2, c = tid & 3;
              const u32x4 v = *(const u32x4*)(A + (size_t)(pm * 128 + r) * lda + k0 + c * 8);
              *(u32x4*)(sA + r * 40 + c * 8) = v; }
#pragma unroll
            for (int p = 0; p < 2; ++p) { const int kk = (tid >> 5) + 16 * p, n4 = (tid & 31) * 4;
              const f32x4 w = *(const f32x4*)(W + (size_t)(k0 + kk) * ldw + pn * 128 + n4);
              sB[(n4 + 0) * 40 + kk] = f2bf(w.x); sB[(n4 + 1) * 40 + kk] = f2bf(w.y); sB[(n4 + 2) * 40 + kk] = f2bf(w.z); sB[(n4 + 3) * 40 + kk] = f2bf(w.w); }
            __syncthreads();
            bf16x8 a[2], b[4];
#pragma unroll
            for (int i = 0; i < 2; ++i) a[i] = *(const bf16x8*)(sA + (32 * wm + 16 * i + fr) * 40 + 8 * fq);
#pragma unroll
            for (int j = 0; j < 4; ++j) b[j] = *(const bf16x8*)(sB + (64 * wn + 16 * j + fr) * 40 + 8 * fq);
#pragma unroll
            for (int i = 0; i < 2; ++i)
#pragma unroll
                for (int j = 0; j < 4; ++j) acc[i][j] = __builtin_amdgcn_mfma_f32_16x16x32_bf16(a[i], b[j], acc[i][j], 0, 0, 0);
            __syncthreads();
        }
#pragma unroll
        for (int i = 0; i < 2; ++i)
#pragma unroll
            for (int j = 0; j < 4; ++j)
#pragma unroll
                for (int e = 0; e < 4; ++e) epi(pm * 128 + 32 * wm + 16 * i + 4 * fq + e, pn * 128 + 64 * wn + 16 * j + fr, acc[i][j][e]);
    }
}
struct EpiStoreBf16 { bf16* O; int ldc; float scale;
    __device__ __forceinline__ void operator()(int r, int c, float v) const { O[(size_t)r * ldc + c] = f2bf(v * scale); } };
struct EpiProj { bf16* O;
    __device__ __forceinline__ void operator()(int r, int c, float v) const { const int t = c >> 9; if (t == 0) v *= 0.125f * LOG2E; O[(size_t)t * M * 512 + (size_t)r * 512 + (c & 511)] = f2bf(v); } };
struct EpiResid { float* C; const float* R;
    __device__ __forceinline__ void operator()(int r, int c, float v) const { C[(size_t)r * DM + c] = R[(size_t)r * DM + c] + v; } };

__device__ __forceinline__ int t5_bucket(int dist) {
    if (dist < 16) return dist;
    const float d = (float)dist;
    int large = 16 + (int)(logf(d / 16.f) / logf(128.f) * 16.f);
    return large < 31 ? large : 31;
}

__device__ __forceinline__ void nattn_dilated(const bf16* Q, const bf16* Kb, const bf16* Vb, const float* rel_bias, bf16* PART, float* STM, float* STL, int gw, int ngw, int lane) {
    const int ntask = 3 * M * NH;
    for (int task = gw; task < ntask; task += ngw) {
        const int p = task / (M * NH), rem = task % (M * NH), row = rem / NH, h = rem % NH;
        const int dil = (p == 0) ? 1 : (p == 1 ? 4 : 16);
        const int t = row % SEQ, i = t / dil, smax = i < 128 ? i : 128;
        const bf16* qp = Q + (size_t)row * 512 + h * 64;
        float sc[3];
#pragma unroll
        for (int j = 0; j < 3; ++j) {
            const int s = lane + 64 * j;
            float v = -INFINITY;
            if (s <= smax) {
                const bf16* kp = Kb + (size_t)(row - s * dil) * 512 + h * 64;
                float d = 0.f;
                for (int c = 0; c < 8; ++c) { const u16x8 qv = *(const u16x8*)(qp + 8 * c), kv = *(const u16x8*)(kp + 8 * c);
#pragma unroll
                    for (int e = 0; e < 8; ++e) d += bf2f(qv[e]) * bf2f(kv[e]); }
                v = d + rel_bias[h * 32 + t5_bucket(s * dil)] * LOG2E;
            }
            sc[j] = v;
        }
        const float m = wave_max(fmaxf(fmaxf(sc[0], sc[1]), sc[2]));
        float pr[3]; float ls = 0.f;
#pragma unroll
        for (int j = 0; j < 3; ++j) { pr[j] = exp2f(sc[j] - m); ls += pr[j]; }
        const float l = wave_sum(ls);
        float acc = 0.f;
        for (int s = 0; s <= smax; ++s) {
            const float ps = __shfl(s < 64 ? pr[0] : (s < 128 ? pr[1] : pr[2]), s & 63);
            acc += ps * bf2f(Vb[(size_t)(row - s * dil) * 512 + h * 64 + lane]);
        }
        PART[(size_t)p * M * 512 + (size_t)row * 512 + h * 64 + lane] = f2bf(acc / l);
        if (lane == 0) { STM[(size_t)p * M * NH + (size_t)row * NH + h] = m; STL[(size_t)p * M * NH + (size_t)row * NH + h] = l; }
    }
}

__device__ __forceinline__ void mix_rows(const bf16* PART, const float* STM, const float* STL, const bf16* GB, const bf16* GC, const bf16* XI, const float* wsc, const float* g_a, const float* g_c,
                                         bf16* MIX, int gw, int ngw, int lane) {
    for (int row = gw; row < M; row += ngw) {
        const int h = lane >> 3, c0 = lane * 8, t = row % SEQ;
        float mp[3], lp[3];
#pragma unroll
        for (int p = 0; p < 3; ++p) { mp[p] = STM[(size_t)p * M * NH + (size_t)row * NH + h]; lp[p] = STL[(size_t)p * M * NH + (size_t)row * NH + h]; }
        const float mall = fmaxf(fmaxf(mp[0], mp[1]), mp[2]);
        float w[3], den = 0.f;
#pragma unroll
        for (int p = 0; p < 3; ++p) { w[p] = lp[p] * exp2f(mp[p] - mall); den += w[p]; }
        const float rden = 1.f / den;
        float o[8];
#pragma unroll
        for (int e = 0; e < 8; ++e) o[e] = 0.f;
#pragma unroll
        for (int p = 0; p < 3; ++p) { const u16x8 v = *(const u16x8*)(PART + (size_t)p * M * 512 + (size_t)row * 512 + c0);
#pragma unroll
            for (int e = 0; e < 8; ++e) o[e] += w[p] * bf2f(v[e]); }
        float ss = 0.f;
#pragma unroll
        for (int e = 0; e < 8; ++e) { o[e] *= rden; ss += o[e] * o[e]; }
        const float rstd_a = rsqrtf(wave_sum(ss) * (1.f / AW) + EPS);
        u32x4 outv;
        { const f32x4 g0 = *(const f32x4*)(g_a + c0), g1 = *(const f32x4*)(g_a + c0 + 4);
          outv.x = pk2(o[0] * rstd_a * g0.x, o[1] * rstd_a * g0.y); outv.y = pk2(o[2] * rstd_a * g0.z, o[3] * rstd_a * g0.w);
          outv.z = pk2(o[4] * rstd_a * g1.x, o[5] * rstd_a * g1.y); outv.w = pk2(o[6] * rstd_a * g1.z, o[7] * rstd_a * g1.w); }
        *(u32x4*)(MIX + (size_t)row * DM + c0) = outv;
        float y[8];
#pragma unroll
        for (int e = 0; e < 8; ++e) y[e] = 0.f;
#pragma unroll
        for (int k = 0; k < 3; ++k) { const int dt = 2 - k;
            if (t - dt >= 0) { const u16x8 gc = *(const u16x8*)(GC + (size_t)(row - dt) * 512 + c0), xi = *(const u16x8*)(XI + (size_t)(row - dt) * 512 + c0);
                const f32x4 w0 = *(const f32x4*)(wsc + k * CW + c0), w1 = *(const f32x4*)(wsc + k * CW + c0 + 4);
                const float wk[8] = {w0.x, w0.y, w0.z, w0.w, w1.x, w1.y, w1.z, w1.w};
#pragma unroll
                for (int e = 0; e < 8; ++e) y[e] += wk[e] * (bf2f(gc[e]) * bf2f(xi[e])); } }
        { const u16x8 gb = *(const u16x8*)(GB + (size_t)row * 512 + c0); ss = 0.f;
#pragma unroll
          for (int e = 0; e < 8; ++e) { y[e] *= bf2f(gb[e]); ss += y[e] * y[e]; } }
        const float rstd_c = rsqrtf(wave_sum(ss) * (1.f / CW) + EPS);
        { const f32x4 g0 = *(const f32x4*)(g_c + c0), g1 = *(const f32x4*)(g_c + c0 + 4);
          outv.x = pk2(y[0] * rstd_c * g0.x, y[1] * rstd_c * g0.y); outv.y = pk2(y[2] * rstd_c * g0.z, y[3] * rstd_c * g0.w);
          outv.z = pk2(y[4] * rstd_c * g1.x, y[5] * rstd_c * g1.y); outv.w = pk2(y[6] * rstd_c * g1.z, y[7] * rstd_c * g1.w); }
        *(u32x4*)(MIX + (size_t)row * DM + AW + c0) = outv;
    }
}

__device__ __forceinline__ void nattn_cross(const bf16* Q2, const bf16* K2, const bf16* V2, bf16* O2, int gw, int ngw, int lane) {
    const int ntask = M * XH;
    for (int task = gw; task < ntask; task += ngw) {
        const int row = task / XH, h = task % XH, b = row / SEQ;
        const bf16* qp = Q2 + (size_t)row * DM + h * XHD;
        float sc[4];
#pragma unroll
        for (int j = 0; j < 4; ++j) { const int mk = lane + 64 * j;
            const bf16* kp = K2 + (size_t)(b * MEML + mk) * DM + h * XHD;
            float d = 0.f;
            for (int c = 0; c < 32; ++c) { const u16x8 qv = *(const u16x8*)(qp + 8 * c), kv = *(const u16x8*)(kp + 8 * c);
#pragma unroll
                for (int e = 0; e < 8; ++e) d += bf2f(qv[e]) * bf2f(kv[e]); }
            sc[j] = d; }
        const float m = wave_max(fmaxf(fmaxf(sc[0], sc[1]), fmaxf(sc[2], sc[3])));
        float pr[4]; float ls = 0.f;
#pragma unroll
        for (int j = 0; j < 4; ++j) { pr[j] = exp2f(sc[j] - m); ls += pr[j]; }
        const float rl = 1.f / wave_sum(ls);
        float acc[4] = {0.f, 0.f, 0.f, 0.f};
        for (int mk = 0; mk < MEML; ++mk) {
            const int j = mk >> 6;
            const float ps = __shfl(j == 0 ? pr[0] : (j == 1 ? pr[1] : (j == 2 ? pr[2] : pr[3])), mk & 63);
            const u16x4 v = *(const u16x4*)(V2 + (size_t)(b * MEML + mk) * DM + h * XHD + lane * 4);
#pragma unroll
            for (int e = 0; e < 4; ++e) acc[e] += ps * bf2f(v[e]);
        }
        unsigned long long o = (unsigned long long)pk2(acc[0] * rl, acc[1] * rl) | ((unsigned long long)pk2(acc[2] * rl, acc[3] * rl) << 32);
        *(unsigned long long*)(O2 + (size_t)row * DM + h * XHD + lane * 4) = o;
    }
}

__device__ __forceinline__ void nffn_act(const bf16* UPH, int row0, const float* wfc, const float* bfc, bf16* ACT, int gtid, int ngt) {
    const int nitem = 8192 * (DFF / 8);
    for (int it = gtid; it < nitem; it += ngt) {
        const int lr = it / (DFF / 8), c0 = (it % (DFF / 8)) * 8, row = row0 + lr, t = row % SEQ;
        float g[8], v[8];
#pragma unroll
        for (int e = 0; e < 8; ++e) { g[e] = bfc[c0 + e]; v[e] = bfc[DFF + c0 + e]; }
#pragma unroll
        for (int k = 0; k < 3; ++k) { const int dt = 2 - k;
            if (t - dt >= 0) { const u16x8 ug = *(const u16x8*)(UPH + (size_t)(lr - dt) * NUP + c0), uv = *(const u16x8*)(UPH + (size_t)(lr - dt) * NUP + DFF + c0);
#pragma unroll
                for (int e = 0; e < 8; ++e) { g[e] += wfc[k * NUP + c0 + e] * bf2f(ug[e]); v[e] += wfc[k * NUP + DFF + c0 + e] * bf2f(uv[e]); } } }
        float a[8];
#pragma unroll
        for (int e = 0; e < 8; ++e) a[e] = g[e] / (1.f + __expf(-g[e])) * v[e];
        u32x4 o; o.x = pk2(a[0], a[1]); o.y = pk2(a[2], a[3]); o.z = pk2(a[4], a[5]); o.w = pk2(a[6], a[7]);
        *(u32x4*)(ACT + (size_t)row * DFF + c0) = o;
    }
}

constexpr int N_PHASES = 16;
__global__ void __launch_bounds__(NTHR, 2) fwd(Args args) {
    extern __shared__ __attribute__((aligned(16))) unsigned char lds[];
    const int tid = threadIdx.x, lane = tid & 63, wave = tid >> 6;
    const int gw = blockIdx.x * NWAVES + wave, ngw = gridDim.x * NWAVES;
    const int gtid = blockIdx.x * NTHR + tid, ngt = gridDim.x * NTHR;
    unsigned char* ws = args.ws;
    const float* x = args.in[0]; const float* mem = args.in[1]; const float* rel_bias = args.in[2]; const float* g_mix = args.in[3]; const float* w_in = args.in[4];
    const float* w_sc = args.in[5]; const float* g_ao = args.in[6]; const float* g_co = args.in[7]; const float* w_out = args.in[8]; const float* g_xa = args.in[9];
    const float* g_mem = args.in[10]; const float* w_xq = args.in[11]; const float* w_xk = args.in[12]; const float* w_xv = args.in[13]; const float* w_xo = args.in[14];
    const float* g_ffn = args.in[15]; const float* w_up = args.in[16]; const float* w_fc = args.in[17]; const float* b_fc = args.in[18]; const float* w_down = args.in[19];
    const float* g_fin = args.in[20];
    float* out = args.out;
    bf16* XN = (bf16*)(ws + WS_XN); bf16* PROJ = (bf16*)(ws + WS_PROJ); bf16* PART = (bf16*)(ws + WS_PART); float* STM = (float*)(ws + WS_STM); float* STL = (float*)(ws + WS_STL);
    bf16* MIX = (bf16*)(ws + WS_MIX); bf16* MEMN = (bf16*)(ws + WS_MEMN); bf16* K2 = (bf16*)(ws + WS_K2); bf16* V2 = (bf16*)(ws + WS_V2);
    bf16* Q2 = (bf16*)(ws + WS_Q2); bf16* O2 = (bf16*)(ws + WS_O2); bf16* UPH = (bf16*)(ws + WS_UPH); bf16* ACT = (bf16*)(ws + WS_ACT);
    const int lo = args.ph_lo, hi = args.ph_hi;
#define IN(k) (lo <= (k) && (k) < hi)
    if (IN(0)) { rms_rows_bf16(x, g_mix, XN, M, gw, ngw, lane); rms_rows_bf16(mem, g_mem, MEMN, MM, gw, ngw, lane); }
    if (IN(1)) {
        ngemm(XN, DM, w_in, NPROJ, M, NPROJ, DM, lds, EpiProj{PROJ});
        ngemm(MEMN, DM, w_xk, DM, MM, DM, DM, lds, EpiStoreBf16{K2, DM, 1.f});
        ngemm(MEMN, DM, w_xv, DM, MM, DM, DM, lds, EpiStoreBf16{V2, DM, 1.f});
    }
    if (IN(2)) nattn_dilated(PROJ, PROJ + (size_t)M * 512, PROJ + (size_t)2 * M * 512, rel_bias, PART, STM, STL, gw, ngw, lane);
    if (IN(3)) mix_rows(PART, STM, STL, PROJ + (size_t)3 * M * 512, PROJ + (size_t)4 * M * 512, PROJ + (size_t)5 * M * 512, w_sc, g_ao, g_co, MIX, gw, ngw, lane);
    if (IN(4)) ngemm(MIX, DM, w_out, DM, M, DM, DM, lds, EpiResid{out, x});
    if (IN(5)) rms_rows_bf16(out, g_xa, XN, M, gw, ngw, lane);
    if (IN(6)) ngemm(XN, DM, w_xq, DM, M, DM, DM, lds, EpiStoreBf16{Q2, DM, 0.0625f * LOG2E});
    if (IN(7)) nattn_cross(Q2, K2, V2, O2, gw, ngw, lane);
    if (IN(8)) ngemm(O2, DM, w_xo, DM, M, DM, DM, lds, EpiResid{out, out});
    if (IN(9)) rms_rows_bf16(out, g_ffn, XN, M, gw, ngw, lane);
    if (IN(10)) ngemm(XN, DM, w_up, NUP, 8192, NUP, DM, lds, EpiStoreBf16{UPH, NUP, 1.f});
    if (IN(11)) nffn_act(UPH, 0, w_fc, b_fc, ACT, gtid, ngt);
    if (IN(12)) ngemm(XN + (size_t)8192 * DM, DM, w_up, NUP, 8192, NUP, DM, lds, EpiStoreBf16{UPH, NUP, 1.f});
    if (IN(13)) nffn_act(UPH, 8192, w_fc, b_fc, ACT, gtid, ngt);
    if (IN(14)) ngemm(ACT, DFF, w_down, DM, M, DM, DFF, lds, EpiResid{out, out});
    if (IN(15)) rms_rows_f32_inplace(out, g_fin, M, gw, ngw, lane);
#undef IN
}

extern "C" void kernel_launch(void* const* d_in, const int* in_sizes, int n_in, void* d_out, int out_size, void* d_ws, size_t ws_size, hipStream_t stream) {
    static int grid = 0;
    if (grid == 0) {
        if (n_in != 21 || out_size != M * DM || ws_size < 256 * MiB) { fprintf(stderr, "kernel_launch: unexpected shapes (n_in %d out %d ws %zu)\n", n_in, out_size, ws_size); grid = -1; return; }
        int dev = 0, cus = 0;
        hipGetDevice(&dev); hipDeviceGetAttribute(&cus, hipDeviceAttributeMultiprocessorCount, dev);
        if (hipFuncSetAttribute((const void*)fwd, hipFuncAttributeMaxDynamicSharedMemorySize, LDS_BYTES) != hipSuccess) { fprintf(stderr, "kernel_launch: hipFuncSetAttribute failed\n"); grid = -1; return; }
        grid = cus > 0 ? cus : 256;
    }
    if (grid < 0) return;
    Args a{};
    for (int i = 0; i < 21; ++i) a.in[i] = (const float*)d_in[i];
    a.out = (float*)d_out; a.ws = (unsigned char*)d_ws;
    for (int ph = 0; ph < N_PHASES; ++ph) {
        a.ph_lo = ph; a.ph_hi = ph + 1;
        hipLaunchKernelGGL(fwd, dim3(grid), dim3(NTHR), LDS_BYTES, stream, a);
    }
}
```

```cpp
#include <hip/hip_runtime.h>
#include <cstdio>
#include <cstdint>

#define LAS __attribute__((address_space(3)))
typedef unsigned short bf16;
typedef short bf16x8 __attribute__((ext_vector_type(8)));
typedef unsigned short u16x8 __attribute__((ext_vector_type(8)));
typedef unsigned short u16x4 __attribute__((ext_vector_type(4)));
typedef float f32x4 __attribute__((ext_vector_type(4)));
typedef unsigned u32x4 __attribute__((ext_vector_type(4)));

constexpr int NB = 4, SEQ = 4096, DM = 1024, M = NB * SEQ;
constexpr int HD = 64, NH = 8, AW = 512, CW = 512, NPROJ = 3072;
constexpr int DFF = 2816, NUP = 2 * DFF;
constexpr int MEML = 256, XH = 4, XHD = 256, MM = NB * MEML;
constexpr float EPS = 1e-6f;
constexpr float LOG2E = 1.4426950408889634f;
constexpr int NTHR = 512, NWAVES = 8;
constexpr int LDS_BYTES = 147456, MISC_OFF = 131072 + 320;

constexpr size_t MiB = 1u << 20;
constexpr size_t WS_XN = 0;
constexpr size_t WS_PROJ = 32 * MiB;
constexpr size_t WS_PART = 128 * MiB;
constexpr size_t WS_STM = 176 * MiB;
constexpr size_t WS_STL = 178 * MiB;
constexpr size_t WS_MIX = 180 * MiB;
constexpr size_t WS_MEMN = 212 * MiB;
constexpr size_t WS_K2 = 214 * MiB;
constexpr size_t WS_V2 = 216 * MiB;
constexpr size_t WS_CTL = 218 * MiB, CTL_BYTES = 64 * 1024;
constexpr size_t WS_Q2 = 32 * MiB;
constexpr size_t WS_O2 = 64 * MiB;
constexpr size_t WS_UPH = 32 * MiB;
constexpr size_t WS_ACT = 120 * MiB;

__device__ __forceinline__ float bf2f(bf16 v) { return __uint_as_float(((unsigned)v) << 16); }
__device__ __forceinline__ bf16 f2bf(float f) { unsigned u = __float_as_uint(f); return (bf16)((u + 0x7fffu + ((u >> 16) & 1u)) >> 16); }
__device__ __forceinline__ unsigned pk2(float lo, float hi) { return (unsigned)f2bf(lo) | ((unsigned)f2bf(hi) << 16); }
__device__ __forceinline__ float wave_sum(float v) {
#pragma unroll
    for (int o = 1; o < 64; o <<= 1) v += __shfl_xor(v, o);
    return v;
}
__device__ __forceinline__ float wave_max(float v) {
#pragma unroll
    for (int o = 1; o < 64; o <<= 1) v = fmaxf(v, __shfl_xor(v, o));
    return v;
}

struct Args {
    const float* in[21];
    float* out;
    unsigned char* ws;
    int ph_lo, ph_hi;
};

__device__ __forceinline__ void rms_rows_bf16(const float* src, const float* g, bf16* dst, int nrows, int gw, int ngw, int lane) {
    for (int r = gw; r < nrows; r += ngw) {
        const f32x4* xr = (const f32x4*)(src + (size_t)r * DM) + lane;
        f32x4 v[4]; float s = 0.f;
#pragma unroll
        for (int j = 0; j < 4; ++j) { v[j] = xr[64 * j]; s += v[j].x * v[j].x + v[j].y * v[j].y + v[j].z * v[j].z + v[j].w * v[j].w; }
        const float rstd = rsqrtf(wave_sum(s) * (1.f / DM) + EPS);
        unsigned long long* o8 = (unsigned long long*)(dst + (size_t)r * DM) + lane;
#pragma unroll
        for (int j = 0; j < 4; ++j) { const f32x4 gv = ((const f32x4*)g)[lane + 64 * j];
            o8[64 * j] = (unsigned long long)pk2(v[j].x * rstd * gv.x, v[j].y * rstd * gv.y) | ((unsigned long long)pk2(v[j].z * rstd * gv.z, v[j].w * rstd * gv.w) << 32); }
    }
}
__device__ __forceinline__ void rms_rows_f32_inplace(float* buf, const float* g, int nrows, int gw, int ngw, int lane) {
    for (int r = gw; r < nrows; r += ngw) {
        f32x4* xr = (f32x4*)(buf + (size_t)r * DM) + lane;
        f32x4 v[4]; float s = 0.f;
#pragma unroll
        for (int j = 0; j < 4; ++j) { v[j] = xr[64 * j]; s += v[j].x * v[j].x + v[j].y * v[j].y + v[j].z * v[j].z + v[j].w * v[j].w; }
        const float rstd = rsqrtf(wave_sum(s) * (1.f / DM) + EPS);
#pragma unroll
        for (int j = 0; j < 4; ++j) { const f32x4 gv = ((const f32x4*)g)[lane + 64 * j]; xr[64 * j] = v[j] * rstd * gv; }
    }
}

template <class Epi>
__device__ __forceinline__ void ngemm(const bf16* A, int lda, const float* W, int ldw, int Mrows, int Ncols, int K, unsigned char* lds, const Epi& epi) {
    bf16* sA = (bf16*)lds;
    bf16* sB = (bf16*)(lds + 128 * 40 * 2);
    const int tid = threadIdx.x, lane = tid & 63, wid = tid >> 6, wm = wid >> 1, wn = wid & 1, fr = lane & 15, fq = lane >> 4;
    const int tm = Mrows / 128, tn = Ncols / 128, nt = tm * tn;
    for (int t = blockIdx.x; t < nt; t += gridDim.x) {
        const int pm = t / tn, pn = t % tn;
        f32x4 acc[2][4];
#pragma unroll
        for (int i = 0; i < 2; ++i)
#pragma unroll
            for (int j = 0; j < 4; ++j) acc[i][j] = (f32x4){0.f, 0.f, 0.f, 0.f};
        for (int k0 = 0; k0 < K; k0 += 32) {
            { const int r = tid >> 2, c = tid & 3;
              const u32x4 v = *(const u32x4*)(A + (size_t)(pm * 128 + r) * lda + k0 + c * 8);
              *(u32x4*)(sA + r * 40 + c * 8) = v; }
#pragma unroll
            for (int p = 0; p < 2; ++p) { const int kk = (tid >> 5) + 16 * p, n4 = (tid & 31) * 4;
              const f32x4 w = *(const f32x4*)(W + (size_t)(k0 + kk) * ldw + pn * 128 + n4);
              sB[(n4 + 0) * 40 + kk] = f2bf(w.x); sB[(n4 + 1) * 40 + kk] = f2bf(w.y); sB[(n4 + 2) * 40 + kk] = f2bf(w.z); sB[(n4 + 3) * 40 + kk] = f2bf(w.w); }
            __syncthreads();
            bf16x8 a[2], b[4];
#pragma unroll
            for (int i = 0; i < 2; ++i) a[i] = *(const bf16x8*)(sA + (32 * wm + 16 * i + fr) * 40 + 8 * fq);
#pragma unroll
            for (int j = 0; j < 4; ++j) b[j] = *(const bf16x8*)(sB + (64 * wn + 16 * j + fr) * 40 + 8 * fq);
#pragma unroll
            for (int i = 0; i < 2; ++i)
#pragma unroll
                for (int j = 0; j < 4; ++j) acc[i][j] = __builtin_amdgcn_mfma_f32_16x16x32_bf16(a[i], b[j], acc[i][j], 0, 0, 0);
            __syncthreads();
        }
#pragma unroll
        for (int i = 0; i < 2; ++i)
#pragma unroll
            for (int j = 0; j < 4; ++j)
#pragma unroll
                for (int e = 0; e < 4; ++e) epi(pm * 128 + 32 * wm + 16 * i + 4 * fq + e, pn * 128 + 64 * wn + 16 * j + fr, acc[i][j][e]);
    }
}
struct EpiStoreBf16 { bf16* O; int ldc; float scale;
    __device__ __forceinline__ void operator()(int r, int c, float v) const { O[(size_t)r * ldc + c] = f2bf(v * scale); } };
struct EpiProj { bf16* O;
    __device__ __forceinline__ void operator()(int r, int c, float v) const { const int t = c >> 9; if (t == 0) v *= 0.125f * LOG2E; O[(size_t)t * M * 512 + (size_t)r * 512 + (c & 511)] = f2bf(v); } };
struct EpiResid { float* C; const float* R;
    __device__ __forceinline__ void operator()(int r, int c, float v) const { C[(size_t)r * DM + c] = R[(size_t)r * DM + c] + v; } };

__device__ __forceinline__ int t5_bucket(int dist) {
    if (dist < 16) return dist;
    const float d = (float)dist;
    int large = 16 + (int)(logf(d / 16.f) / logf(128.f) * 16.f);
    return large < 31 ? large : 31;
}

__device__ __forceinline__ void nattn_dilated(const bf16* Q, const bf16* Kb, const bf16* Vb, const float* rel_bias, bf16* PART, float* STM, float* STL, int gw, int ngw, int lane) {
    const int ntask = 3 * M * NH;
    for (int task = gw; task < ntask; task += ngw) {
        const int p = task / (M * NH), rem = task % (M * NH), row = rem / NH, h = rem % NH;
        const int dil = (p == 0) ? 1 : (p == 1 ? 4 : 16);
        const int t = row % SEQ, i = t / dil, smax = i < 128 ? i : 128;
        const bf16* qp = Q + (size_t)row * 512 + h * 64;
        float sc[3];
#pragma unroll
        for (int j = 0; j < 3; ++j) {
            const int s = lane + 64 * j;
            float v = -INFINITY;
            if (s <= smax) {
                const bf16* kp = Kb + (size_t)(row - s * dil) * 512 + h * 64;
                float d = 0.f;
                for (int c = 0; c < 8; ++c) { const u16x8 qv = *(const u16x8*)(qp + 8 * c), kv = *(const u16x8*)(kp + 8 * c);
#pragma unroll
                    for (int e = 0; e < 8; ++e) d += bf2f(qv[e]) * bf2f(kv[e]); }
                v = d + rel_bias[h * 32 + t5_bucket(s * dil)] * LOG2E;
            }
            sc[j] = v;
        }
        const float m = wave_max(fmaxf(fmaxf(sc[0], sc[1]), sc[2]));
        float pr[3]; float ls = 0.f;
#pragma unroll
        for (int j = 0; j < 3; ++j) { pr[j] = exp2f(sc[j] - m); ls += pr[j]; }
        const float l = wave_sum(ls);
        float acc = 0.f;
        for (int s = 0; s <= smax; ++s) {
            const float ps = __shfl(s < 64 ? pr[0] : (s < 128 ? pr[1] : pr[2]), s & 63);
            acc += ps * bf2f(Vb[(size_t)(row - s * dil) * 512 + h * 64 + lane]);
        }
        PART[(size_t)p * M * 512 + (size_t)row * 512 + h * 64 + lane] = f2bf(acc / l);
        if (lane == 0) { STM[(size_t)p * M * NH + (size_t)row * NH + h] = m; STL[(size_t)p * M * NH + (size_t)row * NH + h] = l; }
    }
}

__device__ __forceinline__ void mix_rows(const bf16* PART, const float* STM, const float* STL, const bf16* GB, const bf16* GC, const bf16* XI, const float* wsc, const float* g_a, const float* g_c,
                                         bf16* MIX, int gw, int ngw, int lane) {
    for (int row = gw; row < M; row += ngw) {
        const int h = lane >> 3, c0 = lane * 8, t = row % SEQ;
        float mp[3], lp[3];
#pragma unroll
        for (int p = 0; p < 3; ++p) { mp[p] = STM[(size_t)p * M * NH + (size_t)row * NH + h]; lp[p] = STL[(size_t)p * M * NH + (size_t)row * NH + h]; }
        const float mall = fmaxf(fmaxf(mp[0], mp[1]), mp[2]);
        float w[3], den = 0.f;
#pragma unroll
        for (int p = 0; p < 3; ++p) { w[p] = lp[p] * exp2f(mp[p] - mall); den += w[p]; }
        const float rden = 1.f / den;
        float o[8];
#pragma unroll
        for (int e = 0; e < 8; ++e) o[e] = 0.f;
#pragma unroll
        for (int p = 0; p < 3; ++p) { const u16x8 v = *(const u16x8*)(PART + (size_t)p * M * 512 + (size_t)row * 512 + c0);
#pragma unroll
            for (int e = 0; e < 8; ++e) o[e] += w[p] * bf2f(v[e]); }
        float ss = 0.f;
#pragma unroll
        for (int e = 0; e < 8; ++e) { o[e] *= rden; ss += o[e] * o[e]; }
        const float rstd_a = rsqrtf(wave_sum(ss) * (1.f / AW) + EPS);
        u32x4 outv;
        { const f32x4 g0 = *(const f32x4*)(g_a + c0), g1 = *(const f32x4*)(g_a + c0 + 4);
          outv.x = pk2(o[0] * rstd_a * g0.x, o[1] * rstd_a * g0.y); outv.y = pk2(o[2] * rstd_a * g0.z, o[3] * rstd_a * g0.w);
          outv.z = pk2(o[4] * rstd_a * g1.x, o[5] * rstd_a * g1.y); outv.w = pk2(o[6] * rstd_a * g1.z, o[7] * rstd_a * g1.w); }
        *(u32x4*)(MIX + (size_t)row * DM + c0) = outv;
        float y[8];
#pragma unroll
        for (int e = 0; e < 8; ++e) y[e] = 0.f;
#pragma unroll
        for (int k = 0; k < 3; ++k) { const int dt = 2 - k;
            if (t - dt >= 0) { const u16x8 gc = *(const u16x8*)(GC + (size_t)(row - dt) * 512 + c0), xi = *(const u16x8*)(XI + (size_t)(row - dt) * 512 + c0);
                const f32x4 w0 = *(const f32x4*)(wsc + k * CW + c0), w1 = *(const f32x4*)(wsc + k * CW + c0 + 4);
                const float wk[8] = {w0.x, w0.y, w0.z, w0.w, w1.x, w1.y, w1.z, w1.w};
#pragma unroll
                for (int e = 0; e < 8; ++e) y[e] += wk[e] * (bf2f(gc[e]) * bf2f(xi[e])); } }
        { const u16x8 gb = *(const u16x8*)(GB + (size_t)row * 512 + c0); ss = 0.f;
#pragma unroll
          for (int e = 0; e < 8; ++e) { y[e] *= bf2f(gb[e]); ss += y[e] * y[e]; } }
        const float rstd_c = rsqrtf(wave_sum(ss) * (1.f / CW) + EPS);
        { const f32x4 g0 = *(const f32x4*)(g_c + c0), g1 = *(const f32x4*)(g_c + c0 + 4);
          outv.x = pk2(y[0] * rstd_c * g0.x, y[1] * rstd_c * g0.y); outv.y = pk2(y[2] * rstd_c * g0.z, y[3] * rstd_c * g0.w);
          outv.z = pk2(y[4] * rstd_c * g1.x, y[5] * rstd_c * g1.y); outv.w = pk2(y[6] * rstd_c * g1.z, y[7] * rstd_c * g1.w); }
        *(u32x4*)(MIX + (size_t)row * DM + AW + c0) = outv;
    }
}

__device__ __forceinline__ void nattn_cross(const bf16* Q2, const bf16* K2, const bf16* V2, bf16* O2, int gw, int ngw, int lane) {
    const int ntask = M * XH;
    for (int task = gw; task < ntask; task += ngw) {
        const int row = task / XH, h = task % XH, b = row / SEQ;
        const bf16* qp = Q2 + (size_t)row * DM + h * XHD;
        float sc[4];
#pragma unroll
        for (int j = 0; j < 4; ++j) { const int mk = lane + 64 * j;
            const bf16* kp = K2 + (size_t)(b * MEML + mk) * DM + h * XHD;
            float d = 0.f;
            for (int c = 0; c < 32; ++c) { const u16x8 qv = *(const u16x8*)(qp + 8 * c), kv = *(const u16x8*)(kp + 8 * c);
#pragma unroll
                for (int e = 0; e < 8; ++e) d += bf2f(qv[e]) * bf2f(kv[e]); }
            sc[j] = d; }
        const float m = wave_max(fmaxf(fmaxf(sc[0], sc[1]), fmaxf(sc[2], sc[3])));
        float pr[4]; float ls = 0.f;
#pragma unroll
        for (int j = 0; j < 4; ++j) { pr[j] = exp2f(sc[j] - m); ls += pr[j]; }
        const float rl = 1.f / wave_sum(ls);
        float acc[4] = {0.f, 0.f, 0.f, 0.f};
        for (int mk = 0; mk < MEML; ++mk) {
            const int j = mk >> 6;
            const float ps = __shfl(j == 0 ? pr[0] : (j == 1 ? pr[1] : (j == 2 ? pr[2] : pr[3])), mk & 63);
            const u16x4 v = *(const u16x4*)(V2 + (size_t)(b * MEML + mk) * DM + h * XHD + lane * 4);
#pragma unroll
            for (int e = 0; e < 4; ++e) acc[e] += ps * bf2f(v[e]);
        }
        unsigned long long o = (unsigned long long)pk2(acc[0] * rl, acc[1] * rl) | ((unsigned long long)pk2(acc[2] * rl, acc[3] * rl) << 32);
        *(unsigned long long*)(O2 + (size_t)row * DM + h * XHD + lane * 4) = o;
    }
}

__device__ __forceinline__ void nffn_act(const bf16* UPH, int row0, const float* wfc, const float* bfc, bf16* ACT, int gtid, int ngt) {
    const int nitem = 8192 * (DFF / 8);
    for (int it = gtid; it < nitem; it += ngt) {
        const int lr = it / (DFF / 8), c0 = (it % (DFF / 8)) * 8, row = row0 + lr, t = row % SEQ;
        float g[8], v[8];
#pragma unroll
        for (int e = 0; e < 8; ++e) { g[e] = bfc[c0 + e]; v[e] = bfc[DFF + c0 + e]; }
#pragma unroll
        for (int k = 0; k < 3; ++k) { const int dt = 2 - k;
            if (t - dt >= 0) { const u16x8 ug = *(const u16x8*)(UPH + (size_t)(lr - dt) * NUP + c0), uv = *(const u16x8*)(UPH + (size_t)(lr - dt) * NUP + DFF + c0);
#pragma unroll
                for (int e = 0; e < 8; ++e) { g[e] += wfc[k * NUP + c0 + e] * bf2f(ug[e]); v[e] += wfc[k * NUP + DFF + c0 + e] * bf2f(uv[e]); } } }
        float a[8];
#pragma unroll
        for (int e = 0; e < 8; ++e) a[e] = g[e] / (1.f + __expf(-g[e])) * v[e];
        u32x4 o; o.x = pk2(a[0], a[1]); o.y = pk2(a[2], a[3]); o.z = pk2(a[4], a[5]); o.w = pk2(a[6], a[7]);
        *(u32x4*)(ACT + (size_t)row * DFF + c0) = o;
    }
}


#define XB_TMO      128
#define XB_XCNT(j)  (256  + 64 * (j))
#define XB_XSUB(j)  (1280 + 64 * (j))
#define XB_XGEN(j)  (2304 + 64 * (j))
#define XB_TOP      3328
#define XB_TOPGEN   3392
#define XCD_BAR_WORDS 3456
#define XB_SPIN_CAP (1u << 18)
__device__ __forceinline__ unsigned xb_ld(unsigned* p)              { return __hip_atomic_load(p, __ATOMIC_RELAXED, __HIP_MEMORY_SCOPE_AGENT); }
__device__ __forceinline__ unsigned xb_add(unsigned* p, unsigned v) { return __hip_atomic_fetch_add(p, v, __ATOMIC_RELAXED, __HIP_MEMORY_SCOPE_AGENT); }
__device__ __forceinline__ unsigned xb_xcc_id() { return (unsigned)__builtin_amdgcn_s_getreg((3 << 11) | 20) & 0xFu; }
#define XB_SPIN(cond, bar) do { unsigned _sp = 0; while (cond) { __builtin_amdgcn_s_sleep(1); \
    if ((++_sp & 255u) == 0u) { if (xb_ld(&(bar)[XB_TMO])) break; if (_sp > XB_SPIN_CAP) { atomicAdd(&(bar)[XB_TMO], 1u); break; } } } } while (0)
struct XcdBarrier { unsigned* bar; unsigned x; volatile LAS unsigned* st; };
__device__ __forceinline__ XcdBarrier xcd_barrier_post(unsigned* bar, volatile LAS unsigned* st) {
    XcdBarrier b; b.bar = bar; b.x = xb_xcc_id(); b.st = st;
    if (threadIdx.x == 0) (void)xb_add(&bar[XB_XCNT(b.x)], 1u);
    return b;
}
__device__ __forceinline__ void xcd_barrier_complete(unsigned* bar, unsigned x, unsigned& nloc, unsigned& nx) {
    const unsigned G = gridDim.x * gridDim.y * gridDim.z;
    unsigned sum, cnt, mine, sp = 0u;
    for (;;) {
        sum = 0u; cnt = 0u; mine = 0u;
#pragma unroll
        for (unsigned j = 0; j < 16; ++j) { const unsigned c = xb_ld(&bar[XB_XCNT(j)]); sum += c; cnt += (c > 0u) ? 1u : 0u; mine = (j == x) ? c : mine; }
        if (sum == G) break;
        __builtin_amdgcn_s_sleep(1);
        if ((++sp & 255u) == 0u) { if (xb_ld(&bar[XB_TMO])) break; if (sp > XB_SPIN_CAP) { atomicAdd(&bar[XB_TMO], 1u); break; } }
    }
    nloc = mine > 0u ? mine : 1u; nx = cnt > 0u ? cnt : 1u;
}
__device__ __forceinline__ void xcd_barrier(const XcdBarrier& b) {
    asm volatile("s_waitcnt vmcnt(0)" ::: "memory");
    __syncthreads();
    if (threadIdx.x == 0) {
        unsigned* bar = b.bar;
        __builtin_amdgcn_s_waitcnt(0);
        unsigned nloc = b.st[0], nx = b.st[1];
        if (nloc == 0u) { xcd_barrier_complete(bar, b.x, nloc, nx); b.st[0] = nloc; b.st[1] = nx; }
        const unsigned old = xb_add(&bar[XB_XSUB(b.x)], 1u);
        const unsigned gen = old / nloc;
        if (old + 1u == (gen + 1u) * nloc) {
            __builtin_amdgcn_fence(__ATOMIC_RELEASE, "agent");
            asm volatile("s_waitcnt vmcnt(0)" ::: "memory");
            const unsigned og = xb_add(&bar[XB_TOP], 1u);
            const unsigned tg = og / nx;
            if (og + 1u == (tg + 1u) * nx) xb_add(&bar[XB_TOPGEN], 1u);
            else XB_SPIN(xb_ld(&bar[XB_TOPGEN]) == tg, bar);
            __builtin_amdgcn_fence(__ATOMIC_ACQUIRE, "agent");
            xb_add(&bar[XB_XGEN(b.x)], 1u);
            asm volatile("s_waitcnt vmcnt(0)" ::: "memory");
        } else {
            XB_SPIN(xb_ld(&bar[XB_XGEN(b.x)]) == gen, bar);
            __builtin_amdgcn_fence(__ATOMIC_ACQUIRE, "agent");
            asm volatile("s_waitcnt vmcnt(0)" ::: "memory");
        }
    }
    __syncthreads();
}

constexpr int N_PHASES = 16;
__global__ void __launch_bounds__(NTHR, 2) fwd(Args args) {
    extern __shared__ __attribute__((aligned(16))) unsigned char lds[];
    const int tid = threadIdx.x, lane = tid & 63, wave = tid >> 6;
    const int gw = blockIdx.x * NWAVES + wave, ngw = gridDim.x * NWAVES;
    const int gtid = blockIdx.x * NTHR + tid, ngt = gridDim.x * NTHR;
    unsigned char* ws = args.ws;
    const float* x = args.in[0]; const float* mem = args.in[1]; const float* rel_bias = args.in[2]; const float* g_mix = args.in[3]; const float* w_in = args.in[4];
    const float* w_sc = args.in[5]; const float* g_ao = args.in[6]; const float* g_co = args.in[7]; const float* w_out = args.in[8]; const float* g_xa = args.in[9];
    const float* g_mem = args.in[10]; const float* w_xq = args.in[11]; const float* w_xk = args.in[12]; const float* w_xv = args.in[13]; const float* w_xo = args.in[14];
    const float* g_ffn = args.in[15]; const float* w_up = args.in[16]; const float* w_fc = args.in[17]; const float* b_fc = args.in[18]; const float* w_down = args.in[19];
    const float* g_fin = args.in[20];
    float* out = args.out;
    bf16* XN = (bf16*)(ws + WS_XN); bf16* PROJ = (bf16*)(ws + WS_PROJ); bf16* PART = (bf16*)(ws + WS_PART); float* STM = (float*)(ws + WS_STM); float* STL = (float*)(ws + WS_STL);
    bf16* MIX = (bf16*)(ws + WS_MIX); bf16* MEMN = (bf16*)(ws + WS_MEMN); bf16* K2 = (bf16*)(ws + WS_K2); bf16* V2 = (bf16*)(ws + WS_V2);
    bf16* Q2 = (bf16*)(ws + WS_Q2); bf16* O2 = (bf16*)(ws + WS_O2); bf16* UPH = (bf16*)(ws + WS_UPH); bf16* ACT = (bf16*)(ws + WS_ACT);
    const int lo = args.ph_lo, hi = args.ph_hi;
    volatile LAS unsigned* MISC = (volatile LAS unsigned*)((LAS unsigned char*)lds + MISC_OFF);
    if (tid < 32) MISC[tid] = 0u;
    __syncthreads();
    XcdBarrier bar = xcd_barrier_post((unsigned*)(ws + WS_CTL) + 1024, MISC + 8);
#define SEAM(k) do { if (IN(k) && IN((k) + 1)) xcd_barrier(bar); } while (0)
#define IN(k) (lo <= (k) && (k) < hi)
    if (IN(0)) { rms_rows_bf16(x, g_mix, XN, M, gw, ngw, lane); rms_rows_bf16(mem, g_mem, MEMN, MM, gw, ngw, lane); }
    SEAM(0);
    if (IN(1)) {
        ngemm(XN, DM, w_in, NPROJ, M, NPROJ, DM, lds, EpiProj{PROJ});
        ngemm(MEMN, DM, w_xk, DM, MM, DM, DM, lds, EpiStoreBf16{K2, DM, 1.f});
        ngemm(MEMN, DM, w_xv, DM, MM, DM, DM, lds, EpiStoreBf16{V2, DM, 1.f});
    }
    SEAM(1);
    if (IN(2)) nattn_dilated(PROJ, PROJ + (size_t)M * 512, PROJ + (size_t)2 * M * 512, rel_bias, PART, STM, STL, gw, ngw, lane);
    SEAM(2);
    if (IN(3)) mix_rows(PART, STM, STL, PROJ + (size_t)3 * M * 512, PROJ + (size_t)4 * M * 512, PROJ + (size_t)5 * M * 512, w_sc, g_ao, g_co, MIX, gw, ngw, lane);
    SEAM(3);
    if (IN(4)) ngemm(MIX, DM, w_out, DM, M, DM, DM, lds, EpiResid{out, x});
    SEAM(4);
    if (IN(5)) rms_rows_bf16(out, g_xa, XN, M, gw, ngw, lane);
    SEAM(5);
    if (IN(6)) ngemm(XN, DM, w_xq, DM, M, DM, DM, lds, EpiStoreBf16{Q2, DM, 0.0625f * LOG2E});
    SEAM(6);
    if (IN(7)) nattn_cross(Q2, K2, V2, O2, gw, ngw, lane);
    SEAM(7);
    if (IN(8)) ngemm(O2, DM, w_xo, DM, M, DM, DM, lds, EpiResid{out, out});
    SEAM(8);
    if (IN(9)) rms_rows_bf16(out, g_ffn, XN, M, gw, ngw, lane);
    SEAM(9);
    if (IN(10)) ngemm(XN, DM, w_up, NUP, 8192, NUP, DM, lds, EpiStoreBf16{UPH, NUP, 1.f});
    SEAM(10);
    if (IN(11)) nffn_act(UPH, 0, w_fc, b_fc, ACT, gtid, ngt);
    SEAM(11);
    if (IN(12)) ngemm(XN + (size_t)8192 * DM, DM, w_up, NUP, 8192, NUP, DM, lds, EpiStoreBf16{UPH, NUP, 1.f});
    SEAM(12);
    if (IN(13)) nffn_act(UPH, 8192, w_fc, b_fc, ACT, gtid, ngt);
    SEAM(13);
    if (IN(14)) ngemm(ACT, DFF, w_down, DM, M, DM, DFF, lds, EpiResid{out, out});
    SEAM(14);
    if (IN(15)) rms_rows_f32_inplace(out, g_fin, M, gw, ngw, lane);
#undef IN
#undef SEAM
}

extern "C" void kernel_launch(void* const* d_in, const int* in_sizes, int n_in, void* d_out, int out_size, void* d_ws, size_t ws_size, hipStream_t stream) {
    static int grid = 0;
    if (grid == 0) {
        if (n_in != 21 || out_size != M * DM || ws_size < 256 * MiB) { fprintf(stderr, "kernel_launch: unexpected shapes (n_in %d out %d ws %zu)\n", n_in, out_size, ws_size); grid = -1; return; }
        int dev = 0, cus = 0;
        (void)hipGetDevice(&dev); (void)hipDeviceGetAttribute(&cus, hipDeviceAttributeMultiprocessorCount, dev);
        if (hipFuncSetAttribute((const void*)fwd, hipFuncAttributeMaxDynamicSharedMemorySize, LDS_BYTES) != hipSuccess) { fprintf(stderr, "kernel_launch: hipFuncSetAttribute failed\n"); grid = -1; return; }
        int per_cu = 0;
        if (hipOccupancyMaxActiveBlocksPerMultiprocessor(&per_cu, (const void*)fwd, NTHR, LDS_BYTES) != hipSuccess || per_cu < 1) { fprintf(stderr, "kernel_launch: occupancy query says %d blocks/CU\n", per_cu); (void)hipGetLastError(); grid = -1; return; }
        grid = (cus > 0 ? cus : 256);
    }
    if (grid < 0) return;
    Args a{};
    for (int i = 0; i < 21; ++i) a.in[i] = (const float*)d_in[i];
    a.out = (float*)d_out; a.ws = (unsigned char*)d_ws;
    if (hipMemsetAsync((char*)d_ws + WS_CTL, 0, CTL_BYTES, stream) != hipSuccess) { fprintf(stderr, "kernel_launch: memset failed\n"); return; }
    a.ph_lo = 0; a.ph_hi = N_PHASES;
    hipLaunchKernelGGL(fwd, dim3(grid), dim3(NTHR), LDS_BYTES, stream, a);
}
```

```cpp
#include <hip/hip_runtime.h>
#include <cstdio>
#include <cstdint>

#define LAS __attribute__((address_space(3)))
typedef unsigned short bf16;
typedef short bf16x8 __attribute__((ext_vector_type(8)));
typedef unsigned short u16x8 __attribute__((ext_vector_type(8)));
typedef unsigned short u16x4 __attribute__((ext_vector_type(4)));
typedef float f32x4 __attribute__((ext_vector_type(4)));
typedef unsigned u32x4 __attribute__((ext_vector_type(4)));

constexpr int NB = 4, SEQ = 4096, DM = 1024, M = NB * SEQ;
constexpr int HD = 64, NH = 8, AW = 512, CW = 512, NPROJ = 3072;
constexpr int DFF = 2816, NUP = 2 * DFF;
constexpr int MEML = 256, XH = 4, XHD = 256, MM = NB * MEML;
constexpr float EPS = 1e-6f;
constexpr float LOG2E = 1.4426950408889634f;
constexpr int NTHR = 512, NWAVES = 8;
constexpr int LDS_BYTES = 147456, MISC_OFF = 131072 + 320;

constexpr size_t MiB = 1u << 20;
constexpr size_t WS_XN = 0;
constexpr size_t WS_PROJ = 32 * MiB;
constexpr size_t WS_PART = 128 * MiB;
constexpr size_t WS_STM = 176 * MiB;
constexpr size_t WS_STL = 178 * MiB;
constexpr size_t WS_MIX = 180 * MiB;
constexpr size_t WS_MEMN = 212 * MiB;
constexpr size_t WS_K2 = 214 * MiB;
constexpr size_t WS_V2 = 216 * MiB;
constexpr size_t WS_CTL = 218 * MiB, CTL_BYTES = 64 * 1024;
constexpr size_t WS_WIN = 220 * MiB, WS_WOUT = 226 * MiB, WS_WXQ = 228 * MiB, WS_WXK = 230 * MiB, WS_WXV = 232 * MiB, WS_WXO = 234 * MiB, WS_WUP = 236 * MiB, WS_WDN = 247 * MiB;
constexpr size_t WS_Q2 = 32 * MiB;
constexpr size_t WS_O2 = 64 * MiB;
constexpr size_t WS_UPH = 32 * MiB;
constexpr size_t WS_ACT = 120 * MiB;

__device__ __forceinline__ float bf2f(bf16 v) { return __uint_as_float(((unsigned)v) << 16); }
__device__ __forceinline__ bf16 f2bf(float f) { unsigned u = __float_as_uint(f); return (bf16)((u + 0x7fffu + ((u >> 16) & 1u)) >> 16); }
__device__ __forceinline__ unsigned pk2(float lo, float hi) { return (unsigned)f2bf(lo) | ((unsigned)f2bf(hi) << 16); }
__device__ __forceinline__ float wave_sum(float v) {
#pragma unroll
    for (int o = 1; o < 64; o <<= 1) v += __shfl_xor(v, o);
    return v;
}
__device__ __forceinline__ float wave_max(float v) {
#pragma unroll
    for (int o = 1; o < 64; o <<= 1) v = fmaxf(v, __shfl_xor(v, o));
    return v;
}

struct Args {
    const float* in[21];
    float* out;
    unsigned char* ws;
    int ph_lo, ph_hi;
};

__device__ __forceinline__ void rms_rows_bf16(const float* src, const float* g, bf16* dst, int nrows, int gw, int ngw, int lane) {
    for (int r = gw; r < nrows; r += ngw) {
        const f32x4* xr = (const f32x4*)(src + (size_t)r * DM) + lane;
        f32x4 v[4]; float s = 0.f;
#pragma unroll
        for (int j = 0; j < 4; ++j) { v[j] = xr[64 * j]; s += v[j].x * v[j].x + v[j].y * v[j].y + v[j].z * v[j].z + v[j].w * v[j].w; }
        const float rstd = rsqrtf(wave_sum(s) * (1.f / DM) + EPS);
        unsigned long long* o8 = (unsigned long long*)(dst + (size_t)r * DM) + lane;
#pragma unroll
        for (int j = 0; j < 4; ++j) { const f32x4 gv = ((const f32x4*)g)[lane + 64 * j];
            o8[64 * j] = (unsigned long long)pk2(v[j].x * rstd * gv.x, v[j].y * rstd * gv.y) | ((unsigned long long)pk2(v[j].z * rstd * gv.z, v[j].w * rstd * gv.w) << 32); }
    }
}
__device__ __forceinline__ void rms_rows_f32_inplace(float* buf, const float* g, int nrows, int gw, int ngw, int lane) {
    for (int r = gw; r < nrows; r += ngw) {
        f32x4* xr = (f32x4*)(buf + (size_t)r * DM) + lane;
        f32x4 v[4]; float s = 0.f;
#pragma unroll
        for (int j = 0; j < 4; ++j) { v[j] = xr[64 * j]; s += v[j].x * v[j].x + v[j].y * v[j].y + v[j].z * v[j].z + v[j].w * v[j].w; }
        const float rstd = rsqrtf(wave_sum(s) * (1.f / DM) + EPS);
#pragma unroll
        for (int j = 0; j < 4; ++j) { const f32x4 gv = ((const f32x4*)g)[lane + 64 * j]; xr[64 * j] = v[j] * rstd * gv; }
    }
}

template <class Epi>
__device__ __forceinline__ void ngemm(const bf16* A, int lda, const float* W, int ldw, int Mrows, int Ncols, int K, unsigned char* lds, const Epi& epi) {
    bf16* sA = (bf16*)lds;
    bf16* sB = (bf16*)(lds + 128 * 40 * 2);
    const int tid = threadIdx.x, lane = tid & 63, wid = tid >> 6, wm = wid >> 1, wn = wid & 1, fr = lane & 15, fq = lane >> 4;
    const int tm = Mrows / 128, tn = Ncols / 128, nt = tm * tn;
    for (int t = blockIdx.x; t < nt; t += gridDim.x) {
        const int pm = t / tn, pn = t % tn;
        f32x4 acc[2][4];
#pragma unroll
        for (int i = 0; i < 2; ++i)
#pragma unroll
            for (int j = 0; j < 4; ++j) acc[i][j] = (f32x4){0.f, 0.f, 0.f, 0.f};
        for (int k0 = 0; k0 < K; k0 += 32) {
            { const int r = tid >> 2, c = tid & 3;
              const u32x4 v = *(const u32x4*)(A + (size_t)(pm * 128 + r) * lda + k0 + c * 8);
              *(u32x4*)(sA + r * 40 + c * 8) = v; }
#pragma unroll
            for (int p = 0; p < 2; ++p) { const int kk = (tid >> 5) + 16 * p, n4 = (tid & 31) * 4;
              const f32x4 w = *(const f32x4*)(W + (size_t)(k0 + kk) * ldw + pn * 128 + n4);
              sB[(n4 + 0) * 40 + kk] = f2bf(w.x); sB[(n4 + 1) * 40 + kk] = f2bf(w.y); sB[(n4 + 2) * 40 + kk] = f2bf(w.z); sB[(n4 + 3) * 40 + kk] = f2bf(w.w); }
            __syncthreads();
            bf16x8 a[2], b[4];
#pragma unroll
            for (int i = 0; i < 2; ++i) a[i] = *(const bf16x8*)(sA + (32 * wm + 16 * i + fr) * 40 + 8 * fq);
#pragma unroll
            for (int j = 0; j < 4; ++j) b[j] = *(const bf16x8*)(sB + (64 * wn + 16 * j + fr) * 40 + 8 * fq);
#pragma unroll
            for (int i = 0; i < 2; ++i)
#pragma unroll
                for (int j = 0; j < 4; ++j) acc[i][j] = __builtin_amdgcn_mfma_f32_16x16x32_bf16(a[i], b[j], acc[i][j], 0, 0, 0);
            __syncthreads();
        }
#pragma unroll
        for (int i = 0; i < 2; ++i)
#pragma unroll
            for (int j = 0; j < 4; ++j)
#pragma unroll
                for (int e = 0; e < 4; ++e) epi(pm * 128 + 32 * wm + 16 * i + 4 * fq + e, pn * 128 + 64 * wn + 16 * j + fr, acc[i][j][e]);
    }
}
struct EpiStoreBf16 { bf16* O; int ldc; float scale;
    __device__ __forceinline__ void operator()(int r, int c, float v) const { O[(size_t)r * ldc + c] = f2bf(v * scale); } };
struct EpiProj { bf16* O;
    __device__ __forceinline__ void operator()(int r, int c, float v) const { const int t = c >> 9; if (t == 0) v *= 0.125f * LOG2E; O[(size_t)t * M * 512 + (size_t)r * 512 + (c & 511)] = f2bf(v); } };
struct EpiResid { float* C; const float* R;
    __device__ __forceinline__ void operator()(int r, int c, float v) const { C[(size_t)r * DM + c] = R[(size_t)r * DM + c] + v; } };

__device__ __forceinline__ int t5_bucket(int dist) {
    if (dist < 16) return dist;
    const float d = (float)dist;
    int large = 16 + (int)(logf(d / 16.f) / logf(128.f) * 16.f);
    return large < 31 ? large : 31;
}

__device__ __forceinline__ void nattn_dilated(const bf16* Q, const bf16* Kb, const bf16* Vb, const float* rel_bias, bf16* PART, float* STM, float* STL, int gw, int ngw, int lane) {
    const int ntask = 3 * M * NH;
    for (int task = gw; task < ntask; task += ngw) {
        const int p = task / (M * NH), rem = task % (M * NH), row = rem / NH, h = rem % NH;
        const int dil = (p == 0) ? 1 : (p == 1 ? 4 : 16);
        const int t = row % SEQ, i = t / dil, smax = i < 128 ? i : 128;
        const bf16* qp = Q + (size_t)row * 512 + h * 64;
        float sc[3];
#pragma unroll
        for (int j = 0; j < 3; ++j) {
            const int s = lane + 64 * j;
            float v = -INFINITY;
            if (s <= smax) {
                const bf16* kp = Kb + (size_t)(row - s * dil) * 512 + h * 64;
                float d = 0.f;
                for (int c = 0; c < 8; ++c) { const u16x8 qv = *(const u16x8*)(qp + 8 * c), kv = *(const u16x8*)(kp + 8 * c);
#pragma unroll
                    for (int e = 0; e < 8; ++e) d += bf2f(qv[e]) * bf2f(kv[e]); }
                v = d + rel_bias[h * 32 + t5_bucket(s * dil)] * LOG2E;
            }
            sc[j] = v;
        }
        const float m = wave_max(fmaxf(fmaxf(sc[0], sc[1]), sc[2]));
        float pr[3]; float ls = 0.f;
#pragma unroll
        for (int j = 0; j < 3; ++j) { pr[j] = exp2f(sc[j] - m); ls += pr[j]; }
        const float l = wave_sum(ls);
        float acc = 0.f;
        for (int s = 0; s <= smax; ++s) {
            const float ps = __shfl(s < 64 ? pr[0] : (s < 128 ? pr[1] : pr[2]), s & 63);
            acc += ps * bf2f(Vb[(size_t)(row - s * dil) * 512 + h * 64 + lane]);
        }
        PART[(size_t)p * M * 512 + (size_t)row * 512 + h * 64 + lane] = f2bf(acc / l);
        if (lane == 0) { STM[(size_t)p * M * NH + (size_t)row * NH + h] = m; STL[(size_t)p * M * NH + (size_t)row * NH + h] = l; }
    }
}


typedef float f32x16 __attribute__((ext_vector_type(16)));
typedef short s16x4 __attribute__((ext_vector_type(4)));
typedef float f32x2_t __attribute__((ext_vector_type(2))); typedef __bf16 bf16x2_t __attribute__((ext_vector_type(2)));
__device__ __forceinline__ unsigned cvtpk(float lo, float hi) { f32x2_t v = {lo, hi}; bf16x2_t b = __builtin_convertvector(v, bf16x2_t); return __builtin_bit_cast(unsigned, b); }
__device__ __forceinline__ s16x4 vtr(const LAS unsigned char* p) { return __builtin_bit_cast(s16x4, __builtin_amdgcn_ds_read_tr16_b64_v4i16((LAS s16x4*)p)); }
constexpr int AT_ROWS = 384, AT_STRIDE = 144, AT_KOFF = 0, AT_VOFF = AT_ROWS * AT_STRIDE, AT_BOFF = 2 * AT_ROWS * AT_STRIDE;
__device__ __forceinline__ void attn_dilated(const bf16* Q, const bf16* Kb, const bf16* Vb, const float* rel_bias, bf16* PART, float* STM, float* STL, LAS unsigned char* lds) {
    const int tid = threadIdx.x, lane = tid & 63, w = __builtin_amdgcn_readfirstlane(tid >> 6), ql = lane & 31, hi = lane >> 5;
    LAS float* bias2 = (LAS float*)(lds + AT_BOFF);
    for (int it = blockIdx.x; it < 1536; it += gridDim.x) {
        const int p = it >> 9, rem = it & 511, b = rem >> 7, h = (rem >> 4) & 7, j16 = rem & 15;
        const int dil = (p == 0) ? 1 : (p == 1 ? 4 : 16), nblk = 16 / dil, res = j16 / nblk, sb = j16 % nblk, i0 = 256 * sb;
        {
            u32x4 kv[6], vv[6];
#pragma unroll
            for (int ps = 0; ps < 6; ++ps) { const int idx = tid + 512 * ps, j = idx >> 3, ch = idx & 7, ki = i0 - 128 + j;
                if (ki >= 0) { const size_t off = (size_t)(b * SEQ + ki * dil + res) * 512 + h * 64 + ch * 8; kv[ps] = *(const u32x4*)(Kb + off); vv[ps] = *(const u32x4*)(Vb + off); }
                else { kv[ps] = (u32x4){0u, 0u, 0u, 0u}; vv[ps] = (u32x4){0u, 0u, 0u, 0u}; } }
#pragma unroll
            for (int ps = 0; ps < 6; ++ps) { const int idx = tid + 512 * ps, j = idx >> 3, ch = idx & 7;
                *(LAS u32x4*)(lds + AT_KOFF + j * AT_STRIDE + ch * 16) = kv[ps]; *(LAS u32x4*)(lds + AT_VOFF + j * AT_STRIDE + ch * 16) = vv[ps]; }
            if (tid <= 128) bias2[tid] = rel_bias[h * 32 + t5_bucket(tid * dil)] * LOG2E;
        }
        const int qi = i0 + 32 * w + ql;
        const size_t grow = (size_t)(b * SEQ + qi * dil + res);
        bf16x8 qf[4];
#pragma unroll
        for (int ks = 0; ks < 4; ++ks) qf[ks] = *(const bf16x8*)(Q + grow * 512 + h * 64 + 16 * ks + 8 * hi);
        __syncthreads();
        float m_run = -INFINITY, l_run = 0.f;
        f32x16 o0 = {}, o1 = {};
        const int g = lane >> 4, i16 = lane & 15, qq = i16 >> 2, pp = i16 & 3;
        const int vlane = (4 * (g >> 1) + qq) * AT_STRIDE + (16 * (g & 1) + 4 * pp) * 2;
        for (int kt = 4; kt >= 0; --kt) {
            if (sb == 0 && w + kt <= 3) continue;
            const int jb = 32 * w + 32 * kt;
            f32x16 s = {};
#pragma unroll
            for (int ks = 0; ks < 4; ++ks) { const bf16x8 a = *(const LAS bf16x8*)(lds + AT_KOFF + (jb + ql) * AT_STRIDE + (16 * ks + 8 * hi) * 2);
                s = __builtin_amdgcn_mfma_f32_32x32x16_bf16(a, qf[ks], s, 0, 0, 0); }
            float mt = -INFINITY;
#pragma unroll
            for (int r = 0; r < 16; ++r) { const int kl = (r & 3) + 8 * (r >> 2) + 4 * hi, steps = 128 + ql - 32 * kt - kl;
                const bool valid = (steps >= 0) && (steps <= 128) && (i0 - 128 + jb + kl >= 0);
                const int sc = steps < 0 ? 0 : (steps > 128 ? 128 : steps);
                const float v = valid ? s[r] + bias2[sc] : -INFINITY;
                s[r] = v; mt = fmaxf(mt, v); }
            mt = fmaxf(mt, __shfl_xor(mt, 32));
            const float m_new = fmaxf(m_run, mt);
            const float alpha = __builtin_amdgcn_exp2f(m_run - m_new);
            m_run = m_new;
            float ps = 0.f;
#pragma unroll
            for (int r = 0; r < 16; ++r) { s[r] = __builtin_amdgcn_exp2f(s[r] - m_new); ps += s[r]; }
            l_run = l_run * alpha + ps;
#pragma unroll
            for (int r = 0; r < 16; ++r) { o0[r] *= alpha; o1[r] *= alpha; }
#pragma unroll
            for (int s2 = 0; s2 < 2; ++s2) {
                u32x4 pw; pw.x = cvtpk(s[8 * s2 + 0], s[8 * s2 + 1]); pw.y = cvtpk(s[8 * s2 + 2], s[8 * s2 + 3]); pw.z = cvtpk(s[8 * s2 + 4], s[8 * s2 + 5]); pw.w = cvtpk(s[8 * s2 + 6], s[8 * s2 + 7]);
                const bf16x8 pf = __builtin_bit_cast(bf16x8, pw);
                const LAS unsigned char* vb = lds + AT_VOFF + (jb + 16 * s2) * AT_STRIDE + vlane;
                const s16x4 a0l = vtr(vb), a0h = vtr(vb + 8 * AT_STRIDE), a1l = vtr(vb + 64), a1h = vtr(vb + 8 * AT_STRIDE + 64);
                const bf16x8 va0 = (bf16x8){a0l[0], a0l[1], a0l[2], a0l[3], a0h[0], a0h[1], a0h[2], a0h[3]};
                const bf16x8 va1 = (bf16x8){a1l[0], a1l[1], a1l[2], a1l[3], a1h[0], a1h[1], a1h[2], a1h[3]};
                o0 = __builtin_amdgcn_mfma_f32_32x32x16_bf16(va0, pf, o0, 0, 0, 0);
                o1 = __builtin_amdgcn_mfma_f32_32x32x16_bf16(va1, pf, o1, 0, 0, 0);
            }
        }
        const float l_tot = l_run + __shfl_xor(l_run, 32);
        const float inv = 1.f / l_tot;
        bf16* op = PART + (size_t)p * M * 512 + grow * 512 + h * 64;
#pragma unroll
        for (int rr = 0; rr < 4; ++rr) {
            const int d = 8 * rr + 4 * hi;
            *(unsigned long long*)(op + d) = (unsigned long long)cvtpk(o0[4 * rr] * inv, o0[4 * rr + 1] * inv) | ((unsigned long long)cvtpk(o0[4 * rr + 2] * inv, o0[4 * rr + 3] * inv) << 32);
            *(unsigned long long*)(op + 32 + d) = (unsigned long long)cvtpk(o1[4 * rr] * inv, o1[4 * rr + 1] * inv) | ((unsigned long long)cvtpk(o1[4 * rr + 2] * inv, o1[4 * rr + 3] * inv) << 32);
        }
        if (hi == 0) { STM[(size_t)p * M * NH + grow * NH + h] = m_run; STL[(size_t)p * M * NH + grow * NH + h] = l_tot; }
        __syncthreads();
    }
}

__device__ __forceinline__ void mix_rows(const bf16* PART, const float* STM, const float* STL, const bf16* GB, const bf16* GC, const bf16* XI, const float* wsc, const float* g_a, const float* g_c,
                                         bf16* MIX, int gw, int ngw, int lane) {
    for (int row = gw; row < M; row += ngw) {
        const int h = lane >> 3, c0 = lane * 8, t = row % SEQ;
        float mp[3], lp[3];
#pragma unroll
        for (int p = 0; p < 3; ++p) { mp[p] = STM[(size_t)p * M * NH + (size_t)row * NH + h]; lp[p] = STL[(size_t)p * M * NH + (size_t)row * NH + h]; }
        const float mall = fmaxf(fmaxf(mp[0], mp[1]), mp[2]);
        float w[3], den = 0.f;
#pragma unroll
        for (int p = 0; p < 3; ++p) { w[p] = lp[p] * exp2f(mp[p] - mall); den += w[p]; }
        const float rden = 1.f / den;
        float o[8];
#pragma unroll
        for (int e = 0; e < 8; ++e) o[e] = 0.f;
#pragma unroll
        for (int p = 0; p < 3; ++p) { const u16x8 v = *(const u16x8*)(PART + (size_t)p * M * 512 + (size_t)row * 512 + c0);
#pragma unroll
            for (int e = 0; e < 8; ++e) o[e] += w[p] * bf2f(v[e]); }
        float ss = 0.f;
#pragma unroll
        for (int e = 0; e < 8; ++e) { o[e] *= rden; ss += o[e] * o[e]; }
        const float rstd_a = rsqrtf(wave_sum(ss) * (1.f / AW) + EPS);
        u32x4 outv;
        { const f32x4 g0 = *(const f32x4*)(g_a + c0), g1 = *(const f32x4*)(g_a + c0 + 4);
          outv.x = pk2(o[0] * rstd_a * g0.x, o[1] * rstd_a * g0.y); outv.y = pk2(o[2] * rstd_a * g0.z, o[3] * rstd_a * g0.w);
          outv.z = pk2(o[4] * rstd_a * g1.x, o[5] * rstd_a * g1.y); outv.w = pk2(o[6] * rstd_a * g1.z, o[7] * rstd_a * g1.w); }
        *(u32x4*)(MIX + (size_t)row * DM + c0) = outv;
        float y[8];
#pragma unroll
        for (int e = 0; e < 8; ++e) y[e] = 0.f;
#pragma unroll
        for (int k = 0; k < 3; ++k) { const int dt = 2 - k;
            if (t - dt >= 0) { const u16x8 gc = *(const u16x8*)(GC + (size_t)(row - dt) * 512 + c0), xi = *(const u16x8*)(XI + (size_t)(row - dt) * 512 + c0);
                const f32x4 w0 = *(const f32x4*)(wsc + k * CW + c0), w1 = *(const f32x4*)(wsc + k * CW + c0 + 4);
                const float wk[8] = {w0.x, w0.y, w0.z, w0.w, w1.x, w1.y, w1.z, w1.w};
#pragma unroll
                for (int e = 0; e < 8; ++e) y[e] += wk[e] * (bf2f(gc[e]) * bf2f(xi[e])); } }
        { const u16x8 gb = *(const u16x8*)(GB + (size_t)row * 512 + c0); ss = 0.f;
#pragma unroll
          for (int e = 0; e < 8; ++e) { y[e] *= bf2f(gb[e]); ss += y[e] * y[e]; } }
        const float rstd_c = rsqrtf(wave_sum(ss) * (1.f / CW) + EPS);
        { const f32x4 g0 = *(const f32x4*)(g_c + c0), g1 = *(const f32x4*)(g_c + c0 + 4);
          outv.x = pk2(y[0] * rstd_c * g0.x, y[1] * rstd_c * g0.y); outv.y = pk2(y[2] * rstd_c * g0.z, y[3] * rstd_c * g0.w);
          outv.z = pk2(y[4] * rstd_c * g1.x, y[5] * rstd_c * g1.y); outv.w = pk2(y[6] * rstd_c * g1.z, y[7] * rstd_c * g1.w); }
        *(u32x4*)(MIX + (size_t)row * DM + AW + c0) = outv;
    }
}


constexpr int XA_STRIDE = 528, XA_KOFF = 0, XA_VOFF = 64 * XA_STRIDE;
__device__ __forceinline__ void attn_cross(const bf16* Q2, const bf16* K2, const bf16* V2, bf16* O2, LAS unsigned char* lds) {
    const int tid = threadIdx.x, lane = tid & 63, w = __builtin_amdgcn_readfirstlane(tid >> 6), fr = lane & 15, g = lane >> 4;
    const int qq = fr >> 2, pp = fr & 3;
    const int vlane = (4 * g + qq) * XA_STRIDE + 4 * pp * 2;
    for (int it = blockIdx.x; it < 512; it += gridDim.x) {
        const int b = it >> 7, h = (it >> 5) & 3, qb = it & 31;
        const bf16* Kh = K2 + (size_t)(b * MEML) * DM + h * XHD;
        const bf16* Vh = V2 + (size_t)(b * MEML) * DM + h * XHD;
        u32x4 pk[4], pv[4];
#define XA_PREFETCH(c) do { _Pragma("unroll") for (int ps = 0; ps < 4; ++ps) { const int idx = tid + 512 * ps, r = idx >> 5, ch = idx & 31; \
            pk[ps] = *(const u32x4*)(Kh + (size_t)(64 * (c) + r) * DM + ch * 8); pv[ps] = *(const u32x4*)(Vh + (size_t)(64 * (c) + r) * DM + ch * 8); } } while (0)
        XA_PREFETCH(0);
        const size_t qrow = (size_t)b * SEQ + qb * 128 + w * 16 + fr;
        bf16x8 qf[8];
#pragma unroll
        for (int ks = 0; ks < 8; ++ks) qf[ks] = *(const bf16x8*)(Q2 + qrow * DM + h * XHD + 32 * ks + 8 * g);
        f32x4 o[16];
#pragma unroll
        for (int dt = 0; dt < 16; ++dt) o[dt] = (f32x4){0.f, 0.f, 0.f, 0.f};
        float m_run = -INFINITY, l_run = 0.f;
        for (int c = 0; c < 4; ++c) {
            __syncthreads();
#pragma unroll
            for (int ps = 0; ps < 4; ++ps) { const int idx = tid + 512 * ps, r = idx >> 5, ch = idx & 31;
                *(LAS u32x4*)(lds + XA_KOFF + r * XA_STRIDE + ch * 16) = pk[ps]; *(LAS u32x4*)(lds + XA_VOFF + r * XA_STRIDE + ch * 16) = pv[ps]; }
            __syncthreads();
            if (c < 3) XA_PREFETCH(c + 1);
            f32x4 s[4];
#pragma unroll
            for (int mt = 0; mt < 4; ++mt) { s[mt] = (f32x4){0.f, 0.f, 0.f, 0.f};
#pragma unroll
                for (int ks = 0; ks < 8; ++ks) { const bf16x8 a = *(const LAS bf16x8*)(lds + XA_KOFF + (16 * mt + fr) * XA_STRIDE + (32 * ks + 8 * g) * 2);
                    s[mt] = __builtin_amdgcn_mfma_f32_16x16x32_bf16(a, qf[ks], s[mt], 0, 0, 0); } }
            float mt_ = -INFINITY;
#pragma unroll
            for (int mt = 0; mt < 4; ++mt) mt_ = fmaxf(mt_, fmaxf(fmaxf(s[mt][0], s[mt][1]), fmaxf(s[mt][2], s[mt][3])));
            mt_ = fmaxf(mt_, __shfl_xor(mt_, 16)); mt_ = fmaxf(mt_, __shfl_xor(mt_, 32));
            const float m_new = fmaxf(m_run, mt_), alpha = __builtin_amdgcn_exp2f(m_run - m_new);
            m_run = m_new;
            float ps_ = 0.f;
#pragma unroll
            for (int mt = 0; mt < 4; ++mt)
#pragma unroll
                for (int i = 0; i < 4; ++i) { s[mt][i] = __builtin_amdgcn_exp2f(s[mt][i] - m_new); ps_ += s[mt][i]; }
            l_run = l_run * alpha + ps_;
#pragma unroll
            for (int dt = 0; dt < 16; ++dt) o[dt] *= alpha;
#pragma unroll
            for (int s2 = 0; s2 < 2; ++s2) {
                u32x4 pw; pw.x = cvtpk(s[2 * s2][0], s[2 * s2][1]); pw.y = cvtpk(s[2 * s2][2], s[2 * s2][3]); pw.z = cvtpk(s[2 * s2 + 1][0], s[2 * s2 + 1][1]); pw.w = cvtpk(s[2 * s2 + 1][2], s[2 * s2 + 1][3]);
                const bf16x8 pf = __builtin_bit_cast(bf16x8, pw);
                const LAS unsigned char* vb = lds + XA_VOFF + (32 * s2) * XA_STRIDE + vlane;
#pragma unroll
                for (int dt = 0; dt < 16; ++dt) {
                    const s16x4 lo = vtr(vb + dt * 32), hi4 = vtr(vb + 16 * XA_STRIDE + dt * 32);
                    const bf16x8 va = (bf16x8){lo[0], lo[1], lo[2], lo[3], hi4[0], hi4[1], hi4[2], hi4[3]};
                    o[dt] = __builtin_amdgcn_mfma_f32_16x16x32_bf16(va, pf, o[dt], 0, 0, 0);
                }
            }
        }
#undef XA_PREFETCH
        float l_tot = l_run + __shfl_xor(l_run, 16); l_tot += __shfl_xor(l_tot, 32);
        const float inv = 1.f / l_tot;
        bf16* op = O2 + qrow * DM + h * XHD + 4 * g;
#pragma unroll
        for (int dt = 0; dt < 16; ++dt)
            *(unsigned long long*)(op + 16 * dt) = (unsigned long long)cvtpk(o[dt][0] * inv, o[dt][1] * inv) | ((unsigned long long)cvtpk(o[dt][2] * inv, o[dt][3] * inv) << 32);
    }
}

__device__ __forceinline__ void nattn_cross(const bf16* Q2, const bf16* K2, const bf16* V2, bf16* O2, int gw, int ngw, int lane) {
    const int ntask = M * XH;
    for (int task = gw; task < ntask; task += ngw) {
        const int row = task / XH, h = task % XH, b = row / SEQ;
        const bf16* qp = Q2 + (size_t)row * DM + h * XHD;
        float sc[4];
#pragma unroll
        for (int j = 0; j < 4; ++j) { const int mk = lane + 64 * j;
            const bf16* kp = K2 + (size_t)(b * MEML + mk) * DM + h * XHD;
            float d = 0.f;
            for (int c = 0; c < 32; ++c) { const u16x8 qv = *(const u16x8*)(qp + 8 * c), kv = *(const u16x8*)(kp + 8 * c);
#pragma unroll
                for (int e = 0; e < 8; ++e) d += bf2f(qv[e]) * bf2f(kv[e]); }
            sc[j] = d; }
        const float m = wave_max(fmaxf(fmaxf(sc[0], sc[1]), fmaxf(sc[2], sc[3])));
        float pr[4]; float ls = 0.f;
#pragma unroll
        for (int j = 0; j < 4; ++j) { pr[j] = exp2f(sc[j] - m); ls += pr[j]; }
        const float rl = 1.f / wave_sum(ls);
        float acc[4] = {0.f, 0.f, 0.f, 0.f};
        for (int mk = 0; mk < MEML; ++mk) {
            const int j = mk >> 6;
            const float ps = __shfl(j == 0 ? pr[0] : (j == 1 ? pr[1] : (j == 2 ? pr[2] : pr[3])), mk & 63);
            const u16x4 v = *(const u16x4*)(V2 + (size_t)(b * MEML + mk) * DM + h * XHD + lane * 4);
#pragma unroll
            for (int e = 0; e < 4; ++e) acc[e] += ps * bf2f(v[e]);
        }
        unsigned long long o = (unsigned long long)pk2(acc[0] * rl, acc[1] * rl) | ((unsigned long long)pk2(acc[2] * rl, acc[3] * rl) << 32);
        *(unsigned long long*)(O2 + (size_t)row * DM + h * XHD + lane * 4) = o;
    }
}

__device__ __forceinline__ void nffn_act(const bf16* UPH, int row0, const float* wfc, const float* bfc, bf16* ACT, int gtid, int ngt) {
    const int nitem = 8192 * (DFF / 8);
    for (int it = gtid; it < nitem; it += ngt) {
        const int lr = it / (DFF / 8), c0 = (it % (DFF / 8)) * 8, row = row0 + lr, t = row % SEQ;
        float g[8], v[8];
#pragma unroll
        for (int e = 0; e < 8; ++e) { g[e] = bfc[c0 + e]; v[e] = bfc[DFF + c0 + e]; }
#pragma unroll
        for (int k = 0; k < 3; ++k) { const int dt = 2 - k;
            if (t - dt >= 0) { const u16x8 ug = *(const u16x8*)(UPH + (size_t)(lr - dt) * NUP + c0), uv = *(const u16x8*)(UPH + (size_t)(lr - dt) * NUP + DFF + c0);
#pragma unroll
                for (int e = 0; e < 8; ++e) { g[e] += wfc[k * NUP + c0 + e] * bf2f(ug[e]); v[e] += wfc[k * NUP + DFF + c0 + e] * bf2f(uv[e]); } } }
        float a[8];
#pragma unroll
        for (int e = 0; e < 8; ++e) a[e] = g[e] / (1.f + __expf(-g[e])) * v[e];
        u32x4 o; o.x = pk2(a[0], a[1]); o.y = pk2(a[2], a[3]); o.z = pk2(a[4], a[5]); o.w = pk2(a[6], a[7]);
        *(u32x4*)(ACT + (size_t)row * DFF + c0) = o;
    }
}


namespace pg8 {
#define PG8_LAS __attribute__((address_space(3)))
typedef unsigned short bf16_t;
typedef short bf16x8 __attribute__((ext_vector_type(8)));
typedef float f32x4 __attribute__((ext_vector_type(4)));
typedef unsigned u32x4 __attribute__((ext_vector_type(4)));
constexpr int BM = 256, BK = 64, HALF = 128, HTB = HALF * BK * 2  , STAGE_BYTES = 8 * HTB, NXCD = 8, WGM = 8;

__host__ __device__ __forceinline__ int lds_byte(int r, int c) { const int st = (r >> 4) * 2 + (c >> 5), rr = r & 15, cc = c & 31, ob = rr * 64 + cc * 2; return st * 1024 + (ob ^ (((ob >> 9) & 1) << 5)); }
__host__ __device__ __forceinline__ void stage_rc(int b, int& R, int& C) { const int st = b / 1024, sb = b % 1024, swz = sb ^ (((sb >> 9) & 1) << 5); R = (st >> 1) * 16 + swz / 64; C = (st & 1) * 32 + (swz % 64) / 2; }
__host__ __device__ __forceinline__ int perm32(int rho) { const int n = rho >> 4, i = rho & 15; return 8 * (i >> 2) + 4 * n + (i & 3); }

struct Unit { int pm, pn; };
struct Gemm { const bf16_t* A; const bf16_t* Bt; int M, N, K; };

struct StaticOrder {
    int nM, nN, nwg, G, c;
    __host__ __device__ void init(int M, int N, int G_, int c_) { nM = M / BM; nN = N / BM; nwg = nM * nN; G = G_; c = c_; }
    __host__ __device__ bool next(int i, Unit& u) const {
        const long L = (long)i * G + c; if (L >= nwg) return false;
        int wgid = (int)L; { const int q = nwg / NXCD, r = nwg % NXCD, xcd = wgid % NXCD, off = wgid / NXCD; wgid = (xcd < r ? xcd * (q + 1) : r * (q + 1) + (xcd - r) * q) + off; }
        const int nig = WGM * nN, gid = wgid / nig, fm = gid * WGM, gsz = (nM - fm) < WGM ? (nM - fm) : WGM;
        u.pm = fm + ((wgid % nig) % gsz); u.pn = (wgid % nig) / gsz; return true;
    }
    __device__ __forceinline__ long arow(const Unit& u) const { return (long)u.pm * BM; }
    __device__ __forceinline__ void a_ready(const Unit&) const {}
    __device__ __forceinline__ void done(const Unit&) const {}
};

__device__ __forceinline__ unsigned cvt_pk_bf16(float lo, float hi) { unsigned r; asm volatile("v_cvt_pk_bf16_f32 %0, %1, %2" : "=v"(r) : "v"(lo), "v"(hi)); return r; }
typedef float f32x2 __attribute__((ext_vector_type(2)));
__device__ __forceinline__ f32x2 gelu_pk(f32x2 v) {
    const f32x2 av = __builtin_elementwise_abs(v), d = av * 0.2316418882f + 1.0f;
    f32x2 t; t.x = __builtin_amdgcn_rcpf(d.x); t.y = __builtin_amdgcn_rcpf(d.y);
    f32x2 q = t * 0.5307027145f + (-0.7265760135f); q = q * t + 0.7107068705f; q = q * t + (-0.142248368f); q = q * t + 0.127414796f; q = q * t;
    const f32x2 s = (v * v) * (-0.72134752044f);
    f32x2 e; e.x = __builtin_amdgcn_exp2f(s.x); e.y = __builtin_amdgcn_exp2f(s.y);
    const f32x2 m = v * (q * e), r = v - m;
    f32x2 o; o.x = v.x < 0.f ? m.x : r.x; o.y = v.y < 0.f ? m.y : r.y; return o;
}

template <int ACT  > struct EpiBf16 {
    static constexpr bool PERM = true, AFTER_DRAIN = false; static_assert(ACT == 0 || ACT == 1, "EpiBf16: ACT is 0 (none) or 1 (gelu_pk)");
    bf16_t* O; int ldc; const float* bias; int split_cols; size_t split_stride; float scale0;
    __device__ __forceinline__ void operator()(const f32x4 (&acc)[2][2][4][2], const Unit& u, int wr, int wc, int fr, int fq) const {
        const int row0 = u.pm * BM + wr * 64 + fr; int colt = u.pn * BM; bf16_t* base = O;
        float sc = 1.f; if (split_cols) { const int t = colt / split_cols; base += (size_t)t * split_stride; colt -= t * split_cols; if (t == 0) sc = scale0; }
        const int col0 = colt + wc * 32 + 8 * fq, bcol0 = u.pn * BM + wc * 32 + 8 * fq;
        f32x4 bv[2][2];
#pragma unroll
        for (int bj = 0; bj < 2; ++bj)
#pragma unroll
            for (int n = 0; n < 2; ++n) bv[bj][n] = bias ? *(const f32x4*)(bias + bcol0 + bj * HALF + 4 * n) : (f32x4){0.f, 0.f, 0.f, 0.f};
#pragma unroll
        for (int ai = 0; ai < 2; ++ai)
#pragma unroll
            for (int m = 0; m < 4; ++m) { bf16_t* rowp = base + (size_t)(row0 + ai * HALF + m * 16) * ldc + col0;
#pragma unroll
                for (int bj = 0; bj < 2; ++bj) { f32x4 v0 = acc[ai][bj][m][0] + bv[bj][0], v1 = acc[ai][bj][m][1] + bv[bj][1];
                    if (ACT == 1) { f32x2 a = gelu_pk((f32x2){v0[0], v0[1]}), b = gelu_pk((f32x2){v0[2], v0[3]}), c = gelu_pk((f32x2){v1[0], v1[1]}), d = gelu_pk((f32x2){v1[2], v1[3]});
                        v0 = (f32x4){a.x, a.y, b.x, b.y}; v1 = (f32x4){c.x, c.y, d.x, d.y}; }
                    v0 = v0 * sc; v1 = v1 * sc; u32x4 w; w.x = cvt_pk_bf16(v0[0], v0[1]); w.y = cvt_pk_bf16(v0[2], v0[3]); w.z = cvt_pk_bf16(v1[0], v1[1]); w.w = cvt_pk_bf16(v1[2], v1[3]);
                    *(u32x4*)(rowp + bj * HALF) = w; } }
    }
};

struct EpiResF32 {
    static constexpr bool PERM = false, AFTER_DRAIN = false;
    float* C; const float* R; int ldc;
    __device__ __forceinline__ void operator()(const f32x4 (&acc)[2][2][4][2], const Unit& u, int wr, int wc, int fr, int fq) const {
        const int row0 = u.pm * BM + wr * 64 + fr, col0 = u.pn * BM + wc * 32 + 4 * fq;
#pragma unroll
        for (int ai = 0; ai < 2; ++ai)
#pragma unroll
            for (int m = 0; m < 4; ++m) { const size_t off = (size_t)(row0 + ai * HALF + m * 16) * ldc + col0;
#pragma unroll
                for (int bj = 0; bj < 2; ++bj)
#pragma unroll
                    for (int n = 0; n < 2; ++n) { const f32x4 r = *(const f32x4*)(R + off + bj * HALF + n * 16); *(f32x4*)(C + off + bj * HALF + n * 16) = r + acc[ai][bj][m][n]; }
                asm volatile("" ::: "memory"); }
    }
};

template <class Epi, class Sched, bool ALIGN_EPI = false, bool SP2 = false>
__device__ __forceinline__ void gemm_phase(PG8_LAS unsigned char* lds, const Gemm g, const Sched& S, const Epi& E) {
    const int tid = threadIdx.x, wid = __builtin_amdgcn_readfirstlane(tid >> 6), lane = tid & 63, wr = wid >> 2, wc = wid & 3, fr = lane & 15, fq = lane >> 4;
    const int K = g.K, nt = K / BK;
    unsigned voffA[2], voffB[2];
#pragma unroll
    for (int i = 0; i < 2; ++i) { int R, C; stage_rc(tid * 16 + i * 8192, R, C); const int Rb = Epi::PERM ? ((R & ~31) + perm32(R & 31)) : R;
        voffA[i] = (unsigned)(R * K + C) * 2u; voffB[i] = (unsigned)(Rb * K + C) * 2u; }
    const size_t kstep = (size_t)(BK * 2);
    const size_t hstep = (size_t)HALF * K * 2;
    const size_t tstep = 2 * hstep;
    const unsigned ldsw = (unsigned)wid * 1024u;
    const int aoff = lds_byte(wr * 64 + fr, fq * 8), boff = lds_byte(wc * 32 + fr, fq * 8);
#define PG8_SA(b, h) (((b) * 2 + (h)) * HTB)
#define PG8_SB(b, h) ((4 + (b) * 2 + (h)) * HTB)
#define PG8_STAGE(bufoff, gbase, voff) do { _Pragma("unroll") for (int _i = 0; _i < 2; ++_i) \
        __builtin_amdgcn_global_load_lds((const unsigned*)((const char*)(gbase) + (voff)[_i]), (PG8_LAS unsigned*)(lds + (bufoff) + ldsw + _i * 8192), 16, 0, 0); } while (0)
#define PG8_LDA(dst, b, h) do { _Pragma("unroll") for (int m = 0; m < 4; ++m) _Pragma("unroll") for (int k = 0; k < 2; ++k) dst[m][k] = *(const PG8_LAS bf16x8*)(lds + PG8_SA(b, h) + aoff + m * 2048 + k * 1024); } while (0)
#define PG8_LDB(dst, b, h) do { _Pragma("unroll") for (int n = 0; n < 2; ++n) _Pragma("unroll") for (int k = 0; k < 2; ++k) dst[n][k] = *(const PG8_LAS bf16x8*)(lds + PG8_SB(b, h) + boff + n * 2048 + k * 1024); } while (0)
#define PG8_MMA(ai, bj, At, Bt) do { __builtin_amdgcn_s_setprio(1); _Pragma("unroll") for (int m = 0; m < 4; ++m) _Pragma("unroll") for (int n = 0; n < 2; ++n) _Pragma("unroll") for (int k = 0; k < 2; ++k) \
        acc[ai][bj][m][n] = __builtin_amdgcn_mfma_f32_16x16x32_bf16(Bt[n][k], At[m][k], acc[ai][bj][m][n], 0, 0, 0); __builtin_amdgcn_s_setprio(0); } while (0)
#define PG8_WAIT_V(n) asm volatile("s_waitcnt vmcnt(" #n ")" ::: "memory")
#define PG8_WAIT_L(n) asm volatile("s_waitcnt lgkmcnt(" #n ")" ::: "memory")
#define PG8_BAR __builtin_amdgcn_s_barrier()
#define PG8_SCHED __builtin_amdgcn_sched_barrier(0)
    Unit cur, nxt; int ui = 0;
    if (!S.next(0, cur)) return;
    f32x4 acc[2][2][4][2];
#pragma unroll
    for (int a = 0; a < 2; ++a)
#pragma unroll
        for (int b = 0; b < 2; ++b)
#pragma unroll
            for (int m = 0; m < 4; ++m)
#pragma unroll
                for (int n = 0; n < 2; ++n) acc[a][b][m][n] = (f32x4){0.f, 0.f, 0.f, 0.f};
    bf16x8 At[4][2], B0[2][2], B1[2][2];
    const size_t rstep = (size_t)K * 2;
    const char* cA = (const char*)g.A + (size_t)S.arow(cur) * rstep; const char* cB = (const char*)g.Bt + (size_t)cur.pn * tstep;
    S.a_ready(cur);
    if constexpr (SP2) {
        PG8_STAGE(PG8_SB(0, 0), cB, voffB); PG8_STAGE(PG8_SB(0, 1), cB + hstep, voffB); PG8_STAGE(PG8_SA(0, 0), cA, voffA); PG8_STAGE(PG8_SA(0, 1), cA + hstep, voffA);
        if (wr == 1) PG8_BAR;
        PG8_WAIT_V(2); PG8_BAR;
        PG8_STAGE(PG8_SB(1, 0), cB + kstep, voffB); PG8_STAGE(PG8_SA(1, 0), cA + kstep, voffA); PG8_STAGE(PG8_SB(1, 1), cB + hstep + kstep, voffB);
        PG8_WAIT_V(6); PG8_BAR;
    } else {
        PG8_STAGE(PG8_SB(0, 0), cB, voffB); PG8_STAGE(PG8_SA(0, 0), cA, voffA); PG8_STAGE(PG8_SB(0, 1), cB + hstep, voffB); PG8_STAGE(PG8_SA(0, 1), cA + hstep, voffA);
        if (wr == 1) PG8_BAR;
        PG8_WAIT_V(4); PG8_BAR;
        PG8_STAGE(PG8_SB(1, 0), cB + kstep, voffB); PG8_STAGE(PG8_SA(1, 0), cA + kstep, voffA); PG8_STAGE(PG8_SB(1, 1), cB + hstep + kstep, voffB);
        PG8_WAIT_V(6); PG8_BAR;
    }
    for (;;) {
        const bool has_next = S.next(ui + 1, nxt);
        const char* nA = has_next ? (const char*)g.A + (size_t)S.arow(nxt) * rstep : cA; const char* nB = has_next ? (const char*)g.Bt + (size_t)nxt.pn * tstep : cB;
        for (int t = 0; t < nt; t += 2) {
            const bool last = (t == nt - 2);
            const char* a1 = cA + (size_t)(t + 1) * kstep;
            const char* a2 = last ? nA : cA + (size_t)(t + 2) * kstep; const char* b2 = last ? nB : cB + (size_t)(t + 2) * kstep;
            const char* a3 = a2 + kstep; const char* b3 = b2 + kstep;
            if (last && has_next) S.a_ready(nxt);
            if constexpr (SP2) {
            PG8_LDB(B0, 0, 0); PG8_LDB(B1, 0, 1); PG8_SCHED; PG8_LDA(At, 0, 0); PG8_STAGE(PG8_SA(1, 1), a1 + hstep, voffA);
            PG8_WAIT_V(8); PG8_WAIT_L(0); PG8_BAR; PG8_MMA(0, 0, At, B0); PG8_MMA(0, 1, At, B1); PG8_BAR; PG8_SCHED;
            PG8_LDA(At, 0, 1); PG8_STAGE(PG8_SB(0, 0), b2, voffB); PG8_STAGE(PG8_SB(0, 1), b2 + hstep, voffB); PG8_STAGE(PG8_SA(0, 0), a2, voffA);
            PG8_WAIT_V(8); PG8_WAIT_L(0); PG8_BAR; PG8_MMA(1, 0, At, B0); PG8_MMA(1, 1, At, B1); PG8_BAR; PG8_SCHED;
            PG8_LDB(B0, 1, 0); PG8_LDB(B1, 1, 1); PG8_SCHED; PG8_LDA(At, 1, 0); PG8_STAGE(PG8_SA(0, 1), a2 + hstep, voffA);
            PG8_WAIT_V(8); PG8_WAIT_L(0); PG8_BAR; PG8_MMA(0, 0, At, B0); PG8_MMA(0, 1, At, B1); PG8_BAR; PG8_SCHED;
            PG8_LDA(At, 1, 1); PG8_STAGE(PG8_SB(1, 0), b3, voffB); PG8_STAGE(PG8_SB(1, 1), b3 + hstep, voffB); PG8_STAGE(PG8_SA(1, 0), a3, voffA);
            PG8_WAIT_V(8); PG8_WAIT_L(0); PG8_BAR; PG8_MMA(1, 0, At, B0); PG8_MMA(1, 1, At, B1); PG8_BAR; PG8_SCHED;
            } else {
            PG8_LDB(B0, 0, 0); PG8_SCHED; PG8_LDA(At, 0, 0); PG8_STAGE(PG8_SA(1, 1), a1 + hstep, voffA);
            PG8_WAIT_L(8); PG8_BAR; PG8_WAIT_L(0); PG8_MMA(0, 0, At, B0); PG8_BAR; PG8_SCHED;
            PG8_LDB(B1, 0, 1); PG8_STAGE(PG8_SB(0, 0), b2, voffB);
            PG8_BAR; PG8_WAIT_L(0); PG8_MMA(0, 1, At, B1); PG8_BAR;
            PG8_LDA(At, 0, 1); PG8_STAGE(PG8_SA(0, 0), a2, voffA);
            PG8_BAR; PG8_WAIT_L(0); PG8_MMA(1, 0, At, B0); PG8_BAR; PG8_SCHED;
            PG8_STAGE(PG8_SB(0, 1), b2 + hstep, voffB);
            PG8_WAIT_V(6); PG8_BAR; PG8_MMA(1, 1, At, B1); PG8_BAR;
            PG8_LDB(B0, 1, 0); PG8_SCHED; PG8_LDA(At, 1, 0); PG8_STAGE(PG8_SA(0, 1), a2 + hstep, voffA);
            PG8_WAIT_L(8); PG8_BAR; PG8_WAIT_L(0); PG8_MMA(0, 0, At, B0); PG8_BAR; PG8_SCHED;
            PG8_LDB(B1, 1, 1); PG8_STAGE(PG8_SB(1, 0), b3, voffB);
            PG8_BAR; PG8_WAIT_L(0); PG8_MMA(0, 1, At, B1); PG8_BAR;
            PG8_LDA(At, 1, 1); PG8_STAGE(PG8_SA(1, 0), a3, voffA);
            PG8_BAR; PG8_WAIT_L(0); PG8_MMA(1, 0, At, B0); PG8_BAR; PG8_SCHED;
            PG8_STAGE(PG8_SB(1, 1), b3 + hstep, voffB);
            PG8_WAIT_V(6); PG8_BAR; PG8_MMA(1, 1, At, B1); PG8_BAR;
            }
        }
        if constexpr (ALIGN_EPI) { if (wr == 0) PG8_BAR; }
        if constexpr (!Epi::AFTER_DRAIN) { E(acc, cur, wr, wc, fr, fq); S.done(cur); }
        if (!has_next) break;
#pragma unroll
        for (int a = 0; a < 2; ++a)
#pragma unroll
            for (int b = 0; b < 2; ++b)
#pragma unroll
                for (int m = 0; m < 4; ++m)
#pragma unroll
                    for (int n = 0; n < 2; ++n) acc[a][b][m][n] = (f32x4){0.f, 0.f, 0.f, 0.f};
        cur = nxt; cA = nA; cB = nB; ++ui;
        if constexpr (ALIGN_EPI) { if (wr == 1) PG8_BAR; }
    }
    PG8_WAIT_V(0);
    if constexpr (!ALIGN_EPI) { if (wr == 0) PG8_BAR; }
    PG8_BAR;
    if constexpr (Epi::AFTER_DRAIN) { E.fused(acc, cur, wr, wc, fr, fq, lds, wid, lane); S.done(cur); }
#undef PG8_SA
#undef PG8_SB
#undef PG8_STAGE
#undef PG8_LDA
#undef PG8_LDB
#undef PG8_MMA
#undef PG8_WAIT_V
#undef PG8_WAIT_L
#undef PG8_BAR
#undef PG8_SCHED
}
}


#define XB_TMO      128
#define XB_XCNT(j)  (256  + 64 * (j))
#define XB_XSUB(j)  (1280 + 64 * (j))
#define XB_XGEN(j)  (2304 + 64 * (j))
#define XB_TOP      3328
#define XB_TOPGEN   3392
#define XCD_BAR_WORDS 3456
#define XB_SPIN_CAP (1u << 18)
__device__ __forceinline__ unsigned xb_ld(unsigned* p)              { return __hip_atomic_load(p, __ATOMIC_RELAXED, __HIP_MEMORY_SCOPE_AGENT); }
__device__ __forceinline__ unsigned xb_add(unsigned* p, unsigned v) { return __hip_atomic_fetch_add(p, v, __ATOMIC_RELAXED, __HIP_MEMORY_SCOPE_AGENT); }
__device__ __forceinline__ unsigned xb_xcc_id() { return (unsigned)__builtin_amdgcn_s_getreg((3 << 11) | 20) & 0xFu; }
#define XB_SPIN(cond, bar) do { unsigned _sp = 0; while (cond) { __builtin_amdgcn_s_sleep(1); \
    if ((++_sp & 255u) == 0u) { if (xb_ld(&(bar)[XB_TMO])) break; if (_sp > XB_SPIN_CAP) { atomicAdd(&(bar)[XB_TMO], 1u); break; } } } } while (0)
struct XcdBarrier { unsigned* bar; unsigned x; volatile LAS unsigned* st; };
__device__ __forceinline__ XcdBarrier xcd_barrier_post(unsigned* bar, volatile LAS unsigned* st) {
    XcdBarrier b; b.bar = bar; b.x = xb_xcc_id(); b.st = st;
    if (threadIdx.x == 0) (void)xb_add(&bar[XB_XCNT(b.x)], 1u);
    return b;
}
__device__ __forceinline__ void xcd_barrier_complete(unsigned* bar, unsigned x, unsigned& nloc, unsigned& nx) {
    const unsigned G = gridDim.x * gridDim.y * gridDim.z;
    unsigned sum, cnt, mine, sp = 0u;
    for (;;) {
        sum = 0u; cnt = 0u; mine = 0u;
#pragma unroll
        for (unsigned j = 0; j < 16; ++j) { const unsigned c = xb_ld(&bar[XB_XCNT(j)]); sum += c; cnt += (c > 0u) ? 1u : 0u; mine = (j == x) ? c : mine; }
        if (sum == G) break;
        __builtin_amdgcn_s_sleep(1);
        if ((++sp & 255u) == 0u) { if (xb_ld(&bar[XB_TMO])) break; if (sp > XB_SPIN_CAP) { atomicAdd(&bar[XB_TMO], 1u); break; } }
    }
    nloc = mine > 0u ? mine : 1u; nx = cnt > 0u ? cnt : 1u;
}
__device__ __forceinline__ void xcd_barrier(const XcdBarrier& b) {
    asm volatile("s_waitcnt vmcnt(0)" ::: "memory");
    __syncthreads();
    if (threadIdx.x == 0) {
        unsigned* bar = b.bar;
        __builtin_amdgcn_s_waitcnt(0);
        unsigned nloc = b.st[0], nx = b.st[1];
        if (nloc == 0u) { xcd_barrier_complete(bar, b.x, nloc, nx); b.st[0] = nloc; b.st[1] = nx; }
        const unsigned old = xb_add(&bar[XB_XSUB(b.x)], 1u);
        const unsigned gen = old / nloc;
        if (old + 1u == (gen + 1u) * nloc) {
            __builtin_amdgcn_fence(__ATOMIC_RELEASE, "agent");
            asm volatile("s_waitcnt vmcnt(0)" ::: "memory");
            const unsigned og = xb_add(&bar[XB_TOP], 1u);
            const unsigned tg = og / nx;
            if (og + 1u == (tg + 1u) * nx) xb_add(&bar[XB_TOPGEN], 1u);
            else XB_SPIN(xb_ld(&bar[XB_TOPGEN]) == tg, bar);
            __builtin_amdgcn_fence(__ATOMIC_ACQUIRE, "agent");
            xb_add(&bar[XB_XGEN(b.x)], 1u);
            asm volatile("s_waitcnt vmcnt(0)" ::: "memory");
        } else {
            XB_SPIN(xb_ld(&bar[XB_XGEN(b.x)]) == gen, bar);
            __builtin_amdgcn_fence(__ATOMIC_ACQUIRE, "agent");
            asm volatile("s_waitcnt vmcnt(0)" ::: "memory");
        }
    }
    __syncthreads();
}


#define LDS_WAIT() asm volatile("s_waitcnt lgkmcnt(0)" ::: "memory")
__device__ __forceinline__ void p0_transpose_item(const float* W, int K, int N, bf16* WT, LAS float* scr, int item, int lane) {
    const int nblk = N / 32, kb = item / nblk, nb = item % nblk, k0 = 64 * kb, n0 = 32 * nb;
#pragma unroll 8
    for (int i = 0; i < 32; ++i) { const int kk = 2 * i + (lane >> 5); scr[kk * 33 + (lane & 31)] = W[(size_t)(k0 + kk) * N + n0 + (lane & 31)]; }
    LDS_WAIT(); asm volatile("" ::: "memory");
    const int c = lane & 7;
#pragma unroll
    for (int j = 0; j < 4; ++j) { const int n = (lane >> 3) + 8 * j; const LAS float* s = scr + (8 * c) * 33 + n;
        u32x4 o; o.x = pk2(s[0 * 33], s[1 * 33]); o.y = pk2(s[2 * 33], s[3 * 33]); o.z = pk2(s[4 * 33], s[5 * 33]); o.w = pk2(s[6 * 33], s[7 * 33]);
        *(u32x4*)(WT + (size_t)(n0 + n) * K + k0 + 8 * c) = o; }
    LDS_WAIT(); asm volatile("" ::: "memory");
}

constexpr int N_PHASES = 16;
__global__ void __launch_bounds__(NTHR, 2) fwd(Args args) {
    extern __shared__ __attribute__((aligned(16))) unsigned char lds[];
    const int tid = threadIdx.x, lane = tid & 63, wave = tid >> 6;
    const int gw = blockIdx.x * NWAVES + wave, ngw = gridDim.x * NWAVES;
    const int gtid = blockIdx.x * NTHR + tid, ngt = gridDim.x * NTHR;
    unsigned char* ws = args.ws;
    const float* x = args.in[0]; const float* mem = args.in[1]; const float* rel_bias = args.in[2]; const float* g_mix = args.in[3]; const float* w_in = args.in[4];
    const float* w_sc = args.in[5]; const float* g_ao = args.in[6]; const float* g_co = args.in[7]; const float* w_out = args.in[8]; const float* g_xa = args.in[9];
    const float* g_mem = args.in[10]; const float* w_xq = args.in[11]; const float* w_xk = args.in[12]; const float* w_xv = args.in[13]; const float* w_xo = args.in[14];
    const float* g_ffn = args.in[15]; const float* w_up = args.in[16]; const float* w_fc = args.in[17]; const float* b_fc = args.in[18]; const float* w_down = args.in[19];
    const float* g_fin = args.in[20];
    float* out = args.out;
    bf16* XN = (bf16*)(ws + WS_XN); bf16* PROJ = (bf16*)(ws + WS_PROJ); bf16* PART = (bf16*)(ws + WS_PART); float* STM = (float*)(ws + WS_STM); float* STL = (float*)(ws + WS_STL);
    bf16* MIX = (bf16*)(ws + WS_MIX); bf16* MEMN = (bf16*)(ws + WS_MEMN); bf16* K2 = (bf16*)(ws + WS_K2); bf16* V2 = (bf16*)(ws + WS_V2);
    bf16* Q2 = (bf16*)(ws + WS_Q2); bf16* O2 = (bf16*)(ws + WS_O2); bf16* UPH = (bf16*)(ws + WS_UPH); bf16* ACT = (bf16*)(ws + WS_ACT);
    bf16* WIN = (bf16*)(ws + WS_WIN); bf16* WOUT = (bf16*)(ws + WS_WOUT); bf16* WXQ = (bf16*)(ws + WS_WXQ); bf16* WXK = (bf16*)(ws + WS_WXK); bf16* WXV = (bf16*)(ws + WS_WXV);
    bf16* WXO = (bf16*)(ws + WS_WXO); bf16* WUP = (bf16*)(ws + WS_WUP); bf16* WDN = (bf16*)(ws + WS_WDN);
    LAS unsigned char* ldsl = (LAS unsigned char*)lds;
    const int G = gridDim.x, bx = blockIdx.x;
    const int lo = args.ph_lo, hi = args.ph_hi;
    volatile LAS unsigned* MISC = (volatile LAS unsigned*)((LAS unsigned char*)lds + MISC_OFF);
    if (tid < 32) MISC[tid] = 0u;
    __syncthreads();
    XcdBarrier bar = xcd_barrier_post((unsigned*)(ws + WS_CTL) + 1024, MISC + 8);
#define SEAM(k) do { if (IN(k) && IN((k) + 1)) xcd_barrier(bar); } while (0)
#define IN(k) (lo <= (k) && (k) < hi)
    if (IN(0)) {
        LAS float* scr = (LAS float*)(ldsl + wave * 16384);
        constexpr int I_IN = (DM / 64) * (NPROJ / 32), I_SQ = (DM / 64) * (DM / 32), I_UP = (DM / 64) * (NUP / 32), I_DN = (DFF / 64) * (DM / 32);
        constexpr int NITEMS = I_IN + 5 * I_SQ + I_UP + I_DN;
        for (int it = gw; it < NITEMS; it += ngw) {
            int r = it;
            if (r < I_IN) { p0_transpose_item(w_in, DM, NPROJ, WIN, scr, r, lane); continue; } r -= I_IN;
            if (r < I_SQ) { p0_transpose_item(w_out, DM, DM, WOUT, scr, r, lane); continue; } r -= I_SQ;
            if (r < I_SQ) { p0_transpose_item(w_xq, DM, DM, WXQ, scr, r, lane); continue; } r -= I_SQ;
            if (r < I_SQ) { p0_transpose_item(w_xk, DM, DM, WXK, scr, r, lane); continue; } r -= I_SQ;
            if (r < I_SQ) { p0_transpose_item(w_xv, DM, DM, WXV, scr, r, lane); continue; } r -= I_SQ;
            if (r < I_SQ) { p0_transpose_item(w_xo, DM, DM, WXO, scr, r, lane); continue; } r -= I_SQ;
            if (r < I_UP) { p0_transpose_item(w_up, DM, NUP, WUP, scr, r, lane); continue; } r -= I_UP;
            p0_transpose_item(w_down, DFF, DM, WDN, scr, r, lane);
        }
        rms_rows_bf16(x, g_mix, XN, M, gw, ngw, lane); rms_rows_bf16(mem, g_mem, MEMN, MM, gw, ngw, lane);
    }
    SEAM(0);
    if (IN(1)) {
        { pg8::Gemm g{XN, WIN, M, NPROJ, DM}; pg8::StaticOrder S; S.init(M, NPROJ, G, bx);
          pg8::EpiBf16<0> E{PROJ, 512, nullptr, 512, (size_t)M * 512, 0.125f * LOG2E};
          pg8::gemm_phase<pg8::EpiBf16<0>, pg8::StaticOrder, true, true>(ldsl, g, S, E); }
        { pg8::Gemm g{MEMN, WXK, MM, DM, DM}; pg8::StaticOrder S; S.init(MM, DM, G, bx);
          pg8::EpiBf16<0> E{K2, DM, nullptr, 0, 0, 1.f};
          pg8::gemm_phase<pg8::EpiBf16<0>, pg8::StaticOrder, true, true>(ldsl, g, S, E); }
        { pg8::Gemm g{MEMN, WXV, MM, DM, DM}; pg8::StaticOrder S; S.init(MM, DM, G, bx);
          pg8::EpiBf16<0> E{V2, DM, nullptr, 0, 0, 1.f};
          pg8::gemm_phase<pg8::EpiBf16<0>, pg8::StaticOrder, true, true>(ldsl, g, S, E); }
    }
    SEAM(1);
    if (IN(2)) attn_dilated(PROJ, PROJ + (size_t)M * 512, PROJ + (size_t)2 * M * 512, rel_bias, PART, STM, STL, ldsl);
    SEAM(2);
    if (IN(3)) mix_rows(PART, STM, STL, PROJ + (size_t)3 * M * 512, PROJ + (size_t)4 * M * 512, PROJ + (size_t)5 * M * 512, w_sc, g_ao, g_co, MIX, gw, ngw, lane);
    SEAM(3);
    if (IN(4)) { pg8::Gemm g{MIX, WOUT, M, DM, DM}; pg8::StaticOrder S; S.init(M, DM, G, bx);
        pg8::EpiResF32 E{out, x, DM};
        pg8::gemm_phase<pg8::EpiResF32, pg8::StaticOrder, true, true>(ldsl, g, S, E); }
    SEAM(4);
    if (IN(5)) rms_rows_bf16(out, g_xa, XN, M, gw, ngw, lane);
    SEAM(5);
    if (IN(6)) { pg8::Gemm g{XN, WXQ, M, DM, DM}; pg8::StaticOrder S; S.init(M, DM, G, bx);
        pg8::EpiBf16<0> E{Q2, DM, nullptr, DM, 0, 0.0625f * LOG2E};
        pg8::gemm_phase<pg8::EpiBf16<0>, pg8::StaticOrder, true, true>(ldsl, g, S, E); }
    SEAM(6);
    if (IN(7)) attn_cross(Q2, K2, V2, O2, ldsl);
    SEAM(7);
    if (IN(8)) { pg8::Gemm g{O2, WXO, M, DM, DM}; pg8::StaticOrder S; S.init(M, DM, G, bx);
        pg8::EpiResF32 E{out, out, DM};
        pg8::gemm_phase<pg8::EpiResF32, pg8::StaticOrder, true, true>(ldsl, g, S, E); }
    SEAM(8);
    if (IN(9)) rms_rows_bf16(out, g_ffn, XN, M, gw, ngw, lane);
    SEAM(9);
    if (IN(10)) { pg8::Gemm g{XN, WUP, 8192, NUP, DM}; pg8::StaticOrder S; S.init(8192, NUP, G, bx);
        pg8::EpiBf16<0> E{UPH, NUP, nullptr, 0, 0, 1.f};
        pg8::gemm_phase<pg8::EpiBf16<0>, pg8::StaticOrder, true, true>(ldsl, g, S, E); }
    SEAM(10);
    if (IN(11)) nffn_act(UPH, 0, w_fc, b_fc, ACT, gtid, ngt);
    SEAM(11);
    if (IN(12)) { pg8::Gemm g{XN + (size_t)8192 * DM, WUP, 8192, NUP, DM}; pg8::StaticOrder S; S.init(8192, NUP, G, bx);
        pg8::EpiBf16<0> E{UPH, NUP, nullptr, 0, 0, 1.f};
        pg8::gemm_phase<pg8::EpiBf16<0>, pg8::StaticOrder, true, true>(ldsl, g, S, E); }
    SEAM(12);
    if (IN(13)) nffn_act(UPH, 8192, w_fc, b_fc, ACT, gtid, ngt);
    SEAM(13);
    if (IN(14)) { pg8::Gemm g{ACT, WDN, M, DM, DFF}; pg8::StaticOrder S; S.init(M, DM, G, bx);
        pg8::EpiResF32 E{out, out, DM};
        pg8::gemm_phase<pg8::EpiResF32, pg8::StaticOrder, true, true>(ldsl, g, S, E); }
    SEAM(14);
    if (IN(15)) rms_rows_f32_inplace(out, g_fin, M, gw, ngw, lane);
#undef IN
#undef SEAM
}

extern "C" void kernel_launch(void* const* d_in, const int* in_sizes, int n_in, void* d_out, int out_size, void* d_ws, size_t ws_size, hipStream_t stream) {
    static int grid = 0;
    if (grid == 0) {
        if (n_in != 21 || out_size != M * DM || ws_size < 256 * MiB) { fprintf(stderr, "kernel_launch: unexpected shapes (n_in %d out %d ws %zu)\n", n_in, out_size, ws_size); grid = -1; return; }
        int dev = 0, cus = 0;
        (void)hipGetDevice(&dev); (void)hipDeviceGetAttribute(&cus, hipDeviceAttributeMultiprocessorCount, dev);
        if (hipFuncSetAttribute((const void*)fwd, hipFuncAttributeMaxDynamicSharedMemorySize, LDS_BYTES) != hipSuccess) { fprintf(stderr, "kernel_launch: hipFuncSetAttribute failed\n"); grid = -1; return; }
        int per_cu = 0;
        if (hipOccupancyMaxActiveBlocksPerMultiprocessor(&per_cu, (const void*)fwd, NTHR, LDS_BYTES) != hipSuccess || per_cu < 1) { fprintf(stderr, "kernel_launch: occupancy query says %d blocks/CU\n", per_cu); (void)hipGetLastError(); grid = -1; return; }
        grid = (cus > 0 ? cus : 256);
    }
    if (grid < 0) return;
    Args a{};
    for (int i = 0; i < 21; ++i) a.in[i] = (const float*)d_in[i];
    a.out = (float*)d_out; a.ws = (unsigned char*)d_ws;
    if (hipMemsetAsync((char*)d_ws + WS_CTL, 0, CTL_BYTES, stream) != hipSuccess) { fprintf(stderr, "kernel_launch: memset failed\n"); return; }
    a.ph_lo = 0; a.ph_hi = N_PHASES;
    hipLaunchKernelGGL(fwd, dim3(grid), dim3(NTHR), LDS_BYTES, stream, a);
}
```

```cpp
#include <hip/hip_runtime.h>
#include <cstdio>
#include <cstdint>

#define LAS __attribute__((address_space(3)))
typedef unsigned short bf16;
typedef short bf16x8 __attribute__((ext_vector_type(8)));
typedef unsigned short u16x8 __attribute__((ext_vector_type(8)));
typedef unsigned short u16x4 __attribute__((ext_vector_type(4)));
typedef float f32x4 __attribute__((ext_vector_type(4)));
typedef unsigned u32x4 __attribute__((ext_vector_type(4)));

constexpr int NB = 4, SEQ = 4096, DM = 1024, M = NB * SEQ;
constexpr int HD = 64, NH = 8, AW = 512, CW = 512, NPROJ = 3072;
constexpr int DFF = 2816, NUP = 2 * DFF;
constexpr int MEML = 256, XH = 4, XHD = 256, MM = NB * MEML;
constexpr float EPS = 1e-6f;
constexpr float LOG2E = 1.4426950408889634f;
constexpr int NTHR = 512, NWAVES = 8;
constexpr int LDS_BYTES = 147456, MISC_OFF = 131072 + 320, XB_OFF = 131072 + 1024;

constexpr size_t MiB = 1u << 20;
constexpr size_t WS_CTL = 0, CTL_BYTES = 64 * 1024;
constexpr size_t WS_XN = 1 * MiB;
constexpr size_t WS_PROJ = 34 * MiB;
constexpr size_t WS_PART = 130 * MiB;
constexpr size_t WS_STM = 178 * MiB;
constexpr size_t WS_STL = 180 * MiB;
constexpr size_t WS_MIX = 182 * MiB;
constexpr size_t WS_MEMN = 214 * MiB;
constexpr size_t WS_K2 = 216 * MiB;
constexpr size_t WS_V2 = 218 * MiB;
constexpr size_t WS_WIN = 220 * MiB, WS_WOUT = 226 * MiB, WS_WXQ = 228 * MiB, WS_WXK = 230 * MiB, WS_WXV = 232 * MiB, WS_WXO = 234 * MiB, WS_WUP = 236 * MiB, WS_WDN = 247 * MiB;
constexpr size_t WS_Q2 = 34 * MiB;
constexpr size_t WS_O2 = 66 * MiB;
constexpr size_t WS_ACT = 98 * MiB;

__device__ __forceinline__ float bf2f(bf16 v) { return __uint_as_float(((unsigned)v) << 16); }
__device__ __forceinline__ bf16 f2bf(float f) { unsigned u = __float_as_uint(f); return (bf16)((u + 0x7fffu + ((u >> 16) & 1u)) >> 16); }
__device__ __forceinline__ unsigned pk2(float lo, float hi) { return (unsigned)f2bf(lo) | ((unsigned)f2bf(hi) << 16); }
__device__ __forceinline__ float wave_sum(float v) {
#pragma unroll
    for (int o = 1; o < 64; o <<= 1) v += __shfl_xor(v, o);
    return v;
}
__device__ __forceinline__ float wave_max(float v) {
#pragma unroll
    for (int o = 1; o < 64; o <<= 1) v = fmaxf(v, __shfl_xor(v, o));
    return v;
}

struct Args {
    const float* in[21];
    float* out;
    unsigned char* ws;
    int ph_lo, ph_hi;
};

__device__ __forceinline__ void rms_rows_bf16(const float* src, const float* g, bf16* dst, int nrows, int gw, int ngw, int lane) {
    for (int r = gw; r < nrows; r += ngw) {
        const f32x4* xr = (const f32x4*)(src + (size_t)r * DM) + lane;
        f32x4 v[4]; float s = 0.f;
#pragma unroll
        for (int j = 0; j < 4; ++j) { v[j] = xr[64 * j]; s += v[j].x * v[j].x + v[j].y * v[j].y + v[j].z * v[j].z + v[j].w * v[j].w; }
        const float rstd = rsqrtf(wave_sum(s) * (1.f / DM) + EPS);
        unsigned long long* o8 = (unsigned long long*)(dst + (size_t)r * DM) + lane;
#pragma unroll
        for (int j = 0; j < 4; ++j) { const f32x4 gv = ((const f32x4*)g)[lane + 64 * j];
            o8[64 * j] = (unsigned long long)pk2(v[j].x * rstd * gv.x, v[j].y * rstd * gv.y) | ((unsigned long long)pk2(v[j].z * rstd * gv.z, v[j].w * rstd * gv.w) << 32); }
    }
}
__device__ __forceinline__ void rms_rows_f32_inplace(float* buf, const float* g, int nrows, int gw, int ngw, int lane) {
    for (int r = gw; r < nrows; r += ngw) {
        f32x4* xr = (f32x4*)(buf + (size_t)r * DM) + lane;
        f32x4 v[4]; float s = 0.f;
#pragma unroll
        for (int j = 0; j < 4; ++j) { v[j] = xr[64 * j]; s += v[j].x * v[j].x + v[j].y * v[j].y + v[j].z * v[j].z + v[j].w * v[j].w; }
        const float rstd = rsqrtf(wave_sum(s) * (1.f / DM) + EPS);
#pragma unroll
        for (int j = 0; j < 4; ++j) { const f32x4 gv = ((const f32x4*)g)[lane + 64 * j]; xr[64 * j] = v[j] * rstd * gv; }
    }
}

template <class Epi>
__device__ __forceinline__ void ngemm(const bf16* A, int lda, const float* W, int ldw, int Mrows, int Ncols, int K, unsigned char* lds, const Epi& epi) {
    bf16* sA = (bf16*)lds;
    bf16* sB = (bf16*)(lds + 128 * 40 * 2);
    const int tid = threadIdx.x, lane = tid & 63, wid = tid >> 6, wm = wid >> 1, wn = wid & 1, fr = lane & 15, fq = lane >> 4;
    const int tm = Mrows / 128, tn = Ncols / 128, nt = tm * tn;
    for (int t = blockIdx.x; t < nt; t += gridDim.x) {
        const int pm = t / tn, pn = t % tn;
        f32x4 acc[2][4];
#pragma unroll
        for (int i = 0; i < 2; ++i)
#pragma unroll
            for (int j = 0; j < 4; ++j) acc[i][j] = (f32x4){0.f, 0.f, 0.f, 0.f};
        for (int k0 = 0; k0 < K; k0 += 32) {
            { const int r = tid >> 2, c = tid & 3;
              const u32x4 v = *(const u32x4*)(A + (size_t)(pm * 128 + r) * lda + k0 + c * 8);
              *(u32x4*)(sA + r * 40 + c * 8) = v; }
#pragma unroll
            for (int p = 0; p < 2; ++p) { const int kk = (tid >> 5) + 16 * p, n4 = (tid & 31) * 4;
              const f32x4 w = *(const f32x4*)(W + (size_t)(k0 + kk) * ldw + pn * 128 + n4);
              sB[(n4 + 0) * 40 + kk] = f2bf(w.x); sB[(n4 + 1) * 40 + kk] = f2bf(w.y); sB[(n4 + 2) * 40 + kk] = f2bf(w.z); sB[(n4 + 3) * 40 + kk] = f2bf(w.w); }
            __syncthreads();
            bf16x8 a[2], b[4];
#pragma unroll
            for (int i = 0; i < 2; ++i) a[i] = *(const bf16x8*)(sA + (32 * wm + 16 * i + fr) * 40 + 8 * fq);
#pragma unroll
            for (int j = 0; j < 4; ++j) b[j] = *(const bf16x8*)(sB + (64 * wn + 16 * j + fr) * 40 + 8 * fq);
#pragma unroll
            for (int i = 0; i < 2; ++i)
#pragma unroll
                for (int j = 0; j < 4; ++j) acc[i][j] = __builtin_amdgcn_mfma_f32_16x16x32_bf16(a[i], b[j], acc[i][j], 0, 0, 0);
            __syncthreads();
        }
#pragma unroll
        for (int i = 0; i < 2; ++i)
#pragma unroll
            for (int j = 0; j < 4; ++j)
#pragma unroll
                for (int e = 0; e < 4; ++e) epi(pm * 128 + 32 * wm + 16 * i + 4 * fq + e, pn * 128 + 64 * wn + 16 * j + fr, acc[i][j][e]);
    }
}
struct EpiStoreBf16 { bf16* O; int ldc; float scale;
    __device__ __forceinline__ void operator()(int r, int c, float v) const { O[(size_t)r * ldc + c] = f2bf(v * scale); } };
struct EpiProj { bf16* O;
    __device__ __forceinline__ void operator()(int r, int c, float v) const { const int t = c >> 9; if (t == 0) v *= 0.125f * LOG2E; O[(size_t)t * M * 512 + (size_t)r * 512 + (c & 511)] = f2bf(v); } };
struct EpiResid { float* C; const float* R;
    __device__ __forceinline__ void operator()(int r, int c, float v) const { C[(size_t)r * DM + c] = R[(size_t)r * DM + c] + v; } };

__device__ __forceinline__ int t5_bucket(int dist) {
    if (dist < 16) return dist;
    const float d = (float)dist;
    int large = 16 + (int)(logf(d / 16.f) / logf(128.f) * 16.f);
    return large < 31 ? large : 31;
}

__device__ __forceinline__ void nattn_dilated(const bf16* Q, const bf16* Kb, const bf16* Vb, const float* rel_bias, bf16* PART, float* STM, float* STL, int gw, int ngw, int lane) {
    const int ntask = 3 * M * NH;
    for (int task = gw; task < ntask; task += ngw) {
        const int p = task / (M * NH), rem = task % (M * NH), row = rem / NH, h = rem % NH;
        const int dil = (p == 0) ? 1 : (p == 1 ? 4 : 16);
        const int t = row % SEQ, i = t / dil, smax = i < 128 ? i : 128;
        const bf16* qp = Q + (size_t)row * 512 + h * 64;
        float sc[3];
#pragma unroll
        for (int j = 0; j < 3; ++j) {
            const int s = lane + 64 * j;
            float v = -INFINITY;
            if (s <= smax) {
                const bf16* kp = Kb + (size_t)(row - s * dil) * 512 + h * 64;
                float d = 0.f;
                for (int c = 0; c < 8; ++c) { const u16x8 qv = *(const u16x8*)(qp + 8 * c), kv = *(const u16x8*)(kp + 8 * c);
#pragma unroll
                    for (int e = 0; e < 8; ++e) d += bf2f(qv[e]) * bf2f(kv[e]); }
                v = d + rel_bias[h * 32 + t5_bucket(s * dil)] * LOG2E;
            }
            sc[j] = v;
        }
        const float m = wave_max(fmaxf(fmaxf(sc[0], sc[1]), sc[2]));
        float pr[3]; float ls = 0.f;
#pragma unroll
        for (int j = 0; j < 3; ++j) { pr[j] = exp2f(sc[j] - m); ls += pr[j]; }
        const float l = wave_sum(ls);
        float acc = 0.f;
        for (int s = 0; s <= smax; ++s) {
            const float ps = __shfl(s < 64 ? pr[0] : (s < 128 ? pr[1] : pr[2]), s & 63);
            acc += ps * bf2f(Vb[(size_t)(row - s * dil) * 512 + h * 64 + lane]);
        }
        PART[(size_t)p * M * 512 + (size_t)row * 512 + h * 64 + lane] = f2bf(acc / l);
        if (lane == 0) { STM[(size_t)p * M * NH + (size_t)row * NH + h] = m; STL[(size_t)p * M * NH + (size_t)row * NH + h] = l; }
    }
}


typedef float f32x16 __attribute__((ext_vector_type(16)));
typedef short s16x4 __attribute__((ext_vector_type(4)));
typedef float f32x2_t __attribute__((ext_vector_type(2))); typedef __bf16 bf16x2_t __attribute__((ext_vector_type(2)));
__device__ __forceinline__ unsigned cvtpk(float lo, float hi) { f32x2_t v = {lo, hi}; bf16x2_t b = __builtin_convertvector(v, bf16x2_t); return __builtin_bit_cast(unsigned, b); }
__device__ __forceinline__ s16x4 vtr(const LAS unsigned char* p) { return __builtin_bit_cast(s16x4, __builtin_amdgcn_ds_read_tr16_b64_v4i16((LAS s16x4*)p)); }
constexpr int AT_ROWS = 384, AT_STRIDE = 144, AT_KOFF = 0, AT_VOFF = AT_ROWS * AT_STRIDE, AT_BOFF = 2 * AT_ROWS * AT_STRIDE;
__device__ __forceinline__ void attn_dilated(const bf16* Q, const bf16* Kb, const bf16* Vb, const float* rel_bias, bf16* PART, float* STM, float* STL, LAS unsigned char* lds) {
    const int tid = threadIdx.x, lane = tid & 63, w = __builtin_amdgcn_readfirstlane(tid >> 6), ql = lane & 31, hi = lane >> 5;
    LAS float* bias2 = (LAS float*)(lds + AT_BOFF);
    for (int it = blockIdx.x; it < 1536; it += gridDim.x) {
        const int p = it >> 9, rem = it & 511, b = rem >> 7, h = (rem >> 4) & 7, j16 = rem & 15;
        const int dil = (p == 0) ? 1 : (p == 1 ? 4 : 16), nblk = 16 / dil, res = j16 / nblk, sb = j16 % nblk, i0 = 256 * sb;
        {
            u32x4 kv[6], vv[6];
#pragma unroll
            for (int ps = 0; ps < 6; ++ps) { const int idx = tid + 512 * ps, j = idx >> 3, ch = idx & 7, ki = i0 - 128 + j;
                if (ki >= 0) { const size_t off = (size_t)(b * SEQ + ki * dil + res) * 512 + h * 64 + ch * 8; kv[ps] = *(const u32x4*)(Kb + off); vv[ps] = *(const u32x4*)(Vb + off); }
                else { kv[ps] = (u32x4){0u, 0u, 0u, 0u}; vv[ps] = (u32x4){0u, 0u, 0u, 0u}; } }
#pragma unroll
            for (int ps = 0; ps < 6; ++ps) { const int idx = tid + 512 * ps, j = idx >> 3, ch = idx & 7;
                *(LAS u32x4*)(lds + AT_KOFF + j * AT_STRIDE + ch * 16) = kv[ps]; *(LAS u32x4*)(lds + AT_VOFF + j * AT_STRIDE + ch * 16) = vv[ps]; }
            if (tid <= 128) bias2[tid] = rel_bias[h * 32 + t5_bucket(tid * dil)] * LOG2E;
        }
        const int qi = i0 + 32 * w + ql;
        const size_t grow = (size_t)(b * SEQ + qi * dil + res);
        bf16x8 qf[4];
#pragma unroll
        for (int ks = 0; ks < 4; ++ks) qf[ks] = *(const bf16x8*)(Q + grow * 512 + h * 64 + 16 * ks + 8 * hi);
        __syncthreads();
        float m_run = -INFINITY, l_run = 0.f;
        f32x16 o0 = {}, o1 = {};
        const int g = lane >> 4, i16 = lane & 15, qq = i16 >> 2, pp = i16 & 3;
        const int vlane = (4 * (g >> 1) + qq) * AT_STRIDE + (16 * (g & 1) + 4 * pp) * 2;
        for (int kt = 4; kt >= 0; --kt) {
            if (sb == 0 && w + kt <= 3) continue;
            const int jb = 32 * w + 32 * kt;
            f32x16 s = {};
#pragma unroll
            for (int ks = 0; ks < 4; ++ks) { const bf16x8 a = *(const LAS bf16x8*)(lds + AT_KOFF + (jb + ql) * AT_STRIDE + (16 * ks + 8 * hi) * 2);
                s = __builtin_amdgcn_mfma_f32_32x32x16_bf16(a, qf[ks], s, 0, 0, 0); }
            float mt = -INFINITY;
#pragma unroll
            for (int r = 0; r < 16; ++r) { const int kl = (r & 3) + 8 * (r >> 2) + 4 * hi, steps = 128 + ql - 32 * kt - kl;
                const bool valid = (steps >= 0) && (steps <= 128) && (i0 - 128 + jb + kl >= 0);
                const int sc = steps < 0 ? 0 : (steps > 128 ? 128 : steps);
                const float v = valid ? s[r] + bias2[sc] : -INFINITY;
                s[r] = v; mt = fmaxf(mt, v); }
            mt = fmaxf(mt, __shfl_xor(mt, 32));
            const float m_new = fmaxf(m_run, mt);
            const float alpha = __builtin_amdgcn_exp2f(m_run - m_new);
            m_run = m_new;
            float ps = 0.f;
#pragma unroll
            for (int r = 0; r < 16; ++r) { s[r] = __builtin_amdgcn_exp2f(s[r] - m_new); ps += s[r]; }
            l_run = l_run * alpha + ps;
#pragma unroll
            for (int r = 0; r < 16; ++r) { o0[r] *= alpha; o1[r] *= alpha; }
#pragma unroll
            for (int s2 = 0; s2 < 2; ++s2) {
                u32x4 pw; pw.x = cvtpk(s[8 * s2 + 0], s[8 * s2 + 1]); pw.y = cvtpk(s[8 * s2 + 2], s[8 * s2 + 3]); pw.z = cvtpk(s[8 * s2 + 4], s[8 * s2 + 5]); pw.w = cvtpk(s[8 * s2 + 6], s[8 * s2 + 7]);
                const bf16x8 pf = __builtin_bit_cast(bf16x8, pw);
                const LAS unsigned char* vb = lds + AT_VOFF + (jb + 16 * s2) * AT_STRIDE + vlane;
                const s16x4 a0l = vtr(vb), a0h = vtr(vb + 8 * AT_STRIDE), a1l = vtr(vb + 64), a1h = vtr(vb + 8 * AT_STRIDE + 64);
                const bf16x8 va0 = (bf16x8){a0l[0], a0l[1], a0l[2], a0l[3], a0h[0], a0h[1], a0h[2], a0h[3]};
                const bf16x8 va1 = (bf16x8){a1l[0], a1l[1], a1l[2], a1l[3], a1h[0], a1h[1], a1h[2], a1h[3]};
                o0 = __builtin_amdgcn_mfma_f32_32x32x16_bf16(va0, pf, o0, 0, 0, 0);
                o1 = __builtin_amdgcn_mfma_f32_32x32x16_bf16(va1, pf, o1, 0, 0, 0);
            }
        }
        const float l_tot = l_run + __shfl_xor(l_run, 32);
        const float inv = 1.f / l_tot;
        bf16* op = PART + (size_t)p * M * 512 + grow * 512 + h * 64;
#pragma unroll
        for (int rr = 0; rr < 4; ++rr) {
            const int d = 8 * rr + 4 * hi;
            *(unsigned long long*)(op + d) = (unsigned long long)cvtpk(o0[4 * rr] * inv, o0[4 * rr + 1] * inv) | ((unsigned long long)cvtpk(o0[4 * rr + 2] * inv, o0[4 * rr + 3] * inv) << 32);
            *(unsigned long long*)(op + 32 + d) = (unsigned long long)cvtpk(o1[4 * rr] * inv, o1[4 * rr + 1] * inv) | ((unsigned long long)cvtpk(o1[4 * rr + 2] * inv, o1[4 * rr + 3] * inv) << 32);
        }
        if (hi == 0) { STM[(size_t)p * M * NH + grow * NH + h] = m_run; STL[(size_t)p * M * NH + grow * NH + h] = l_tot; }
        __syncthreads();
    }
}

__device__ __forceinline__ void mix_rows(const bf16* PART, const float* STM, const float* STL, const bf16* GB, const bf16* GC, const bf16* XI, const float* wsc, const float* g_a, const float* g_c,
                                         bf16* MIX, int gw, int ngw, int lane) {
    for (int row = gw; row < M; row += ngw) {
        const int h = lane >> 3, c0 = lane * 8, t = row % SEQ;
        float mp[3], lp[3];
#pragma unroll
        for (int p = 0; p < 3; ++p) { mp[p] = STM[(size_t)p * M * NH + (size_t)row * NH + h]; lp[p] = STL[(size_t)p * M * NH + (size_t)row * NH + h]; }
        const float mall = fmaxf(fmaxf(mp[0], mp[1]), mp[2]);
        float w[3], den = 0.f;
#pragma unroll
        for (int p = 0; p < 3; ++p) { w[p] = lp[p] * exp2f(mp[p] - mall); den += w[p]; }
        const float rden = 1.f / den;
        float o[8];
#pragma unroll
        for (int e = 0; e < 8; ++e) o[e] = 0.f;
#pragma unroll
        for (int p = 0; p < 3; ++p) { const u16x8 v = *(const u16x8*)(PART + (size_t)p * M * 512 + (size_t)row * 512 + c0);
#pragma unroll
            for (int e = 0; e < 8; ++e) o[e] += w[p] * bf2f(v[e]); }
        float ss = 0.f;
#pragma unroll
        for (int e = 0; e < 8; ++e) { o[e] *= rden; ss += o[e] * o[e]; }
        const float rstd_a = rsqrtf(wave_sum(ss) * (1.f / AW) + EPS);
        u32x4 outv;
        { const f32x4 g0 = *(const f32x4*)(g_a + c0), g1 = *(const f32x4*)(g_a + c0 + 4);
          outv.x = pk2(o[0] * rstd_a * g0.x, o[1] * rstd_a * g0.y); outv.y = pk2(o[2] * rstd_a * g0.z, o[3] * rstd_a * g0.w);
          outv.z = pk2(o[4] * rstd_a * g1.x, o[5] * rstd_a * g1.y); outv.w = pk2(o[6] * rstd_a * g1.z, o[7] * rstd_a * g1.w); }
        *(u32x4*)(MIX + (size_t)row * DM + c0) = outv;
        float y[8];
#pragma unroll
        for (int e = 0; e < 8; ++e) y[e] = 0.f;
#pragma unroll
        for (int k = 0; k < 3; ++k) { const int dt = 2 - k;
            if (t - dt >= 0) { const u16x8 gc = *(const u16x8*)(GC + (size_t)(row - dt) * 512 + c0), xi = *(const u16x8*)(XI + (size_t)(row - dt) * 512 + c0);
                const f32x4 w0 = *(const f32x4*)(wsc + k * CW + c0), w1 = *(const f32x4*)(wsc + k * CW + c0 + 4);
                const float wk[8] = {w0.x, w0.y, w0.z, w0.w, w1.x, w1.y, w1.z, w1.w};
#pragma unroll
                for (int e = 0; e < 8; ++e) y[e] += wk[e] * (bf2f(gc[e]) * bf2f(xi[e])); } }
        { const u16x8 gb = *(const u16x8*)(GB + (size_t)row * 512 + c0); ss = 0.f;
#pragma unroll
          for (int e = 0; e < 8; ++e) { y[e] *= bf2f(gb[e]); ss += y[e] * y[e]; } }
        const float rstd_c = rsqrtf(wave_sum(ss) * (1.f / CW) + EPS);
        { const f32x4 g0 = *(const f32x4*)(g_c + c0), g1 = *(const f32x4*)(g_c + c0 + 4);
          outv.x = pk2(y[0] * rstd_c * g0.x, y[1] * rstd_c * g0.y); outv.y = pk2(y[2] * rstd_c * g0.z, y[3] * rstd_c * g0.w);
          outv.z = pk2(y[4] * rstd_c * g1.x, y[5] * rstd_c * g1.y); outv.w = pk2(y[6] * rstd_c * g1.z, y[7] * rstd_c * g1.w); }
        *(u32x4*)(MIX + (size_t)row * DM + AW + c0) = outv;
    }
}


constexpr int XA_STRIDE = 528, XA_KOFF = 0, XA_VOFF = 64 * XA_STRIDE;
__device__ __forceinline__ void attn_cross(const bf16* Q2, const bf16* K2, const bf16* V2, bf16* O2, LAS unsigned char* lds) {
    const int tid = threadIdx.x, lane = tid & 63, w = __builtin_amdgcn_readfirstlane(tid >> 6), fr = lane & 15, g = lane >> 4;
    const int qq = fr >> 2, pp = fr & 3;
    const int vlane = (4 * g + qq) * XA_STRIDE + 4 * pp * 2;
    for (int it = blockIdx.x; it < 512; it += gridDim.x) {
        const int b = it >> 7, h = (it >> 5) & 3, qb = it & 31;
        const bf16* Kh = K2 + (size_t)(b * MEML) * DM + h * XHD;
        const bf16* Vh = V2 + (size_t)(b * MEML) * DM + h * XHD;
        u32x4 pk[4], pv[4];
#define XA_PREFETCH(c) do { _Pragma("unroll") for (int ps = 0; ps < 4; ++ps) { const int idx = tid + 512 * ps, r = idx >> 5, ch = idx & 31; \
            pk[ps] = *(const u32x4*)(Kh + (size_t)(64 * (c) + r) * DM + ch * 8); pv[ps] = *(const u32x4*)(Vh + (size_t)(64 * (c) + r) * DM + ch * 8); } } while (0)
        XA_PREFETCH(0);
        const size_t qrow = (size_t)b * SEQ + qb * 128 + w * 16 + fr;
        bf16x8 qf[8];
#pragma unroll
        for (int ks = 0; ks < 8; ++ks) qf[ks] = *(const bf16x8*)(Q2 + qrow * DM + h * XHD + 32 * ks + 8 * g);
        f32x4 o[16];
#pragma unroll
        for (int dt = 0; dt < 16; ++dt) o[dt] = (f32x4){0.f, 0.f, 0.f, 0.f};
        float m_run = -INFINITY, l_run = 0.f;
        for (int c = 0; c < 4; ++c) {
            __syncthreads();
#pragma unroll
            for (int ps = 0; ps < 4; ++ps) { const int idx = tid + 512 * ps, r = idx >> 5, ch = idx & 31;
                *(LAS u32x4*)(lds + XA_KOFF + r * XA_STRIDE + ch * 16) = pk[ps]; *(LAS u32x4*)(lds + XA_VOFF + r * XA_STRIDE + ch * 16) = pv[ps]; }
            __syncthreads();
            if (c < 3) XA_PREFETCH(c + 1);
            f32x4 s[4];
#pragma unroll
            for (int mt = 0; mt < 4; ++mt) { s[mt] = (f32x4){0.f, 0.f, 0.f, 0.f};
#pragma unroll
                for (int ks = 0; ks < 8; ++ks) { const bf16x8 a = *(const LAS bf16x8*)(lds + XA_KOFF + (16 * mt + fr) * XA_STRIDE + (32 * ks + 8 * g) * 2);
                    s[mt] = __builtin_amdgcn_mfma_f32_16x16x32_bf16(a, qf[ks], s[mt], 0, 0, 0); } }
            float mt_ = -INFINITY;
#pragma unroll
            for (int mt = 0; mt < 4; ++mt) mt_ = fmaxf(mt_, fmaxf(fmaxf(s[mt][0], s[mt][1]), fmaxf(s[mt][2], s[mt][3])));
            mt_ = fmaxf(mt_, __shfl_xor(mt_, 16)); mt_ = fmaxf(mt_, __shfl_xor(mt_, 32));
            const float m_new = fmaxf(m_run, mt_), alpha = __builtin_amdgcn_exp2f(m_run - m_new);
            m_run = m_new;
            float ps_ = 0.f;
#pragma unroll
            for (int mt = 0; mt < 4; ++mt)
#pragma unroll
                for (int i = 0; i < 4; ++i) { s[mt][i] = __builtin_amdgcn_exp2f(s[mt][i] - m_new); ps_ += s[mt][i]; }
            l_run = l_run * alpha + ps_;
#pragma unroll
            for (int dt = 0; dt < 16; ++dt) o[dt] *= alpha;
#pragma unroll
            for (int s2 = 0; s2 < 2; ++s2) {
                u32x4 pw; pw.x = cvtpk(s[2 * s2][0], s[2 * s2][1]); pw.y = cvtpk(s[2 * s2][2], s[2 * s2][3]); pw.z = cvtpk(s[2 * s2 + 1][0], s[2 * s2 + 1][1]); pw.w = cvtpk(s[2 * s2 + 1][2], s[2 * s2 + 1][3]);
                const bf16x8 pf = __builtin_bit_cast(bf16x8, pw);
                const LAS unsigned char* vb = lds + XA_VOFF + (32 * s2) * XA_STRIDE + vlane;
#pragma unroll
                for (int dt = 0; dt < 16; ++dt) {
                    const s16x4 lo = vtr(vb + dt * 32), hi4 = vtr(vb + 16 * XA_STRIDE + dt * 32);
                    const bf16x8 va = (bf16x8){lo[0], lo[1], lo[2], lo[3], hi4[0], hi4[1], hi4[2], hi4[3]};
                    o[dt] = __builtin_amdgcn_mfma_f32_16x16x32_bf16(va, pf, o[dt], 0, 0, 0);
                }
            }
        }
#undef XA_PREFETCH
        float l_tot = l_run + __shfl_xor(l_run, 16); l_tot += __shfl_xor(l_tot, 32);
        const float inv = 1.f / l_tot;
        bf16* op = O2 + qrow * DM + h * XHD + 4 * g;
#pragma unroll
        for (int dt = 0; dt < 16; ++dt)
            *(unsigned long long*)(op + 16 * dt) = (unsigned long long)cvtpk(o[dt][0] * inv, o[dt][1] * inv) | ((unsigned long long)cvtpk(o[dt][2] * inv, o[dt][3] * inv) << 32);
    }
}

__device__ __forceinline__ void nattn_cross(const bf16* Q2, const bf16* K2, const bf16* V2, bf16* O2, int gw, int ngw, int lane) {
    const int ntask = M * XH;
    for (int task = gw; task < ntask; task += ngw) {
        const int row = task / XH, h = task % XH, b = row / SEQ;
        const bf16* qp = Q2 + (size_t)row * DM + h * XHD;
        float sc[4];
#pragma unroll
        for (int j = 0; j < 4; ++j) { const int mk = lane + 64 * j;
            const bf16* kp = K2 + (size_t)(b * MEML + mk) * DM + h * XHD;
            float d = 0.f;
            for (int c = 0; c < 32; ++c) { const u16x8 qv = *(const u16x8*)(qp + 8 * c), kv = *(const u16x8*)(kp + 8 * c);
#pragma unroll
                for (int e = 0; e < 8; ++e) d += bf2f(qv[e]) * bf2f(kv[e]); }
            sc[j] = d; }
        const float m = wave_max(fmaxf(fmaxf(sc[0], sc[1]), fmaxf(sc[2], sc[3])));
        float pr[4]; float ls = 0.f;
#pragma unroll
        for (int j = 0; j < 4; ++j) { pr[j] = exp2f(sc[j] - m); ls += pr[j]; }
        const float rl = 1.f / wave_sum(ls);
        float acc[4] = {0.f, 0.f, 0.f, 0.f};
        for (int mk = 0; mk < MEML; ++mk) {
            const int j = mk >> 6;
            const float ps = __shfl(j == 0 ? pr[0] : (j == 1 ? pr[1] : (j == 2 ? pr[2] : pr[3])), mk & 63);
            const u16x4 v = *(const u16x4*)(V2 + (size_t)(b * MEML + mk) * DM + h * XHD + lane * 4);
#pragma unroll
            for (int e = 0; e < 4; ++e) acc[e] += ps * bf2f(v[e]);
        }
        unsigned long long o = (unsigned long long)pk2(acc[0] * rl, acc[1] * rl) | ((unsigned long long)pk2(acc[2] * rl, acc[3] * rl) << 32);
        *(unsigned long long*)(O2 + (size_t)row * DM + h * XHD + lane * 4) = o;
    }
}

__device__ __forceinline__ void nffn_act(const bf16* UPH, int row0, const float* wfc, const float* bfc, bf16* ACT, int gtid, int ngt) {
    const int nitem = 8192 * (DFF / 8);
    for (int it = gtid; it < nitem; it += ngt) {
        const int lr = it / (DFF / 8), c0 = (it % (DFF / 8)) * 8, row = row0 + lr, t = row % SEQ;
        float g[8], v[8];
#pragma unroll
        for (int e = 0; e < 8; ++e) { g[e] = bfc[c0 + e]; v[e] = bfc[DFF + c0 + e]; }
#pragma unroll
        for (int k = 0; k < 3; ++k) { const int dt = 2 - k;
            if (t - dt >= 0) { const u16x8 ug = *(const u16x8*)(UPH + (size_t)(lr - dt) * NUP + c0), uv = *(const u16x8*)(UPH + (size_t)(lr - dt) * NUP + DFF + c0);
#pragma unroll
                for (int e = 0; e < 8; ++e) { g[e] += wfc[k * NUP + c0 + e] * bf2f(ug[e]); v[e] += wfc[k * NUP + DFF + c0 + e] * bf2f(uv[e]); } } }
        float a[8];
#pragma unroll
        for (int e = 0; e < 8; ++e) a[e] = g[e] / (1.f + __expf(-g[e])) * v[e];
        u32x4 o; o.x = pk2(a[0], a[1]); o.y = pk2(a[2], a[3]); o.z = pk2(a[4], a[5]); o.w = pk2(a[6], a[7]);
        *(u32x4*)(ACT + (size_t)row * DFF + c0) = o;
    }
}


namespace pg8 {
#define PG8_LAS __attribute__((address_space(3)))
typedef unsigned short bf16_t;
typedef short bf16x8 __attribute__((ext_vector_type(8)));
typedef float f32x4 __attribute__((ext_vector_type(4)));
typedef unsigned u32x4 __attribute__((ext_vector_type(4)));
constexpr int BM = 256, BK = 64, HALF = 128, HTB = HALF * BK * 2  , STAGE_BYTES = 8 * HTB, NXCD = 8, WGM = 8;

__host__ __device__ __forceinline__ int lds_byte(int r, int c) { const int st = (r >> 4) * 2 + (c >> 5), rr = r & 15, cc = c & 31, ob = rr * 64 + cc * 2; return st * 1024 + (ob ^ (((ob >> 9) & 1) << 5)); }
__host__ __device__ __forceinline__ void stage_rc(int b, int& R, int& C) { const int st = b / 1024, sb = b % 1024, swz = sb ^ (((sb >> 9) & 1) << 5); R = (st >> 1) * 16 + swz / 64; C = (st & 1) * 32 + (swz % 64) / 2; }
__host__ __device__ __forceinline__ int perm32(int rho) { const int n = rho >> 4, i = rho & 15; return 8 * (i >> 2) + 4 * n + (i & 3); }

struct Unit { int pm, pn; };
struct Gemm { const bf16_t* A; const bf16_t* Bt; int M, N, K; };

struct StaticOrder {
    int nM, nN, nwg, G, c;
    __host__ __device__ void init(int M, int N, int G_, int c_) { nM = M / BM; nN = N / BM; nwg = nM * nN; G = G_; c = c_; }
    __host__ __device__ bool next(int i, Unit& u) const {
        const long L = (long)i * G + c; if (L >= nwg) return false;
        int wgid = (int)L; { const int q = nwg / NXCD, r = nwg % NXCD, xcd = wgid % NXCD, off = wgid / NXCD; wgid = (xcd < r ? xcd * (q + 1) : r * (q + 1) + (xcd - r) * q) + off; }
        const int nig = WGM * nN, gid = wgid / nig, fm = gid * WGM, gsz = (nM - fm) < WGM ? (nM - fm) : WGM;
        u.pm = fm + ((wgid % nig) % gsz); u.pn = (wgid % nig) / gsz; return true;
    }
    __device__ __forceinline__ long arow(const Unit& u) const { return (long)u.pm * BM; }
    __device__ __forceinline__ void a_ready(const Unit&) const {}
    __device__ __forceinline__ void done(const Unit&) const {}
};

__device__ __forceinline__ unsigned cvt_pk_bf16(float lo, float hi) { unsigned r; asm volatile("v_cvt_pk_bf16_f32 %0, %1, %2" : "=v"(r) : "v"(lo), "v"(hi)); return r; }
typedef float f32x2 __attribute__((ext_vector_type(2)));
__device__ __forceinline__ f32x2 gelu_pk(f32x2 v) {
    const f32x2 av = __builtin_elementwise_abs(v), d = av * 0.2316418882f + 1.0f;
    f32x2 t; t.x = __builtin_amdgcn_rcpf(d.x); t.y = __builtin_amdgcn_rcpf(d.y);
    f32x2 q = t * 0.5307027145f + (-0.7265760135f); q = q * t + 0.7107068705f; q = q * t + (-0.142248368f); q = q * t + 0.127414796f; q = q * t;
    const f32x2 s = (v * v) * (-0.72134752044f);
    f32x2 e; e.x = __builtin_amdgcn_exp2f(s.x); e.y = __builtin_amdgcn_exp2f(s.y);
    const f32x2 m = v * (q * e), r = v - m;
    f32x2 o; o.x = v.x < 0.f ? m.x : r.x; o.y = v.y < 0.f ? m.y : r.y; return o;
}

template <int ACT  > struct EpiBf16 {
    static constexpr bool PERM = true, AFTER_DRAIN = false; static_assert(ACT == 0 || ACT == 1, "EpiBf16: ACT is 0 (none) or 1 (gelu_pk)");
    bf16_t* O; int ldc; const float* bias; int split_cols; size_t split_stride; float scale0;
    __device__ __forceinline__ void operator()(const f32x4 (&acc)[2][2][4][2], const Unit& u, int wr, int wc, int fr, int fq) const {
        const int row0 = u.pm * BM + wr * 64 + fr; int colt = u.pn * BM; bf16_t* base = O;
        float sc = 1.f; if (split_cols) { const int t = colt / split_cols; base += (size_t)t * split_stride; colt -= t * split_cols; if (t == 0) sc = scale0; }
        const int col0 = colt + wc * 32 + 8 * fq, bcol0 = u.pn * BM + wc * 32 + 8 * fq;
        f32x4 bv[2][2];
#pragma unroll
        for (int bj = 0; bj < 2; ++bj)
#pragma unroll
            for (int n = 0; n < 2; ++n) bv[bj][n] = bias ? *(const f32x4*)(bias + bcol0 + bj * HALF + 4 * n) : (f32x4){0.f, 0.f, 0.f, 0.f};
#pragma unroll
        for (int ai = 0; ai < 2; ++ai)
#pragma unroll
            for (int m = 0; m < 4; ++m) { bf16_t* rowp = base + (size_t)(row0 + ai * HALF + m * 16) * ldc + col0;
#pragma unroll
                for (int bj = 0; bj < 2; ++bj) { f32x4 v0 = acc[ai][bj][m][0] + bv[bj][0], v1 = acc[ai][bj][m][1] + bv[bj][1];
                    if (ACT == 1) { f32x2 a = gelu_pk((f32x2){v0[0], v0[1]}), b = gelu_pk((f32x2){v0[2], v0[3]}), c = gelu_pk((f32x2){v1[0], v1[1]}), d = gelu_pk((f32x2){v1[2], v1[3]});
                        v0 = (f32x4){a.x, a.y, b.x, b.y}; v1 = (f32x4){c.x, c.y, d.x, d.y}; }
                    v0 = v0 * sc; v1 = v1 * sc; u32x4 w; w.x = cvt_pk_bf16(v0[0], v0[1]); w.y = cvt_pk_bf16(v0[2], v0[3]); w.z = cvt_pk_bf16(v1[0], v1[1]); w.w = cvt_pk_bf16(v1[2], v1[3]);
                    *(u32x4*)(rowp + bj * HALF) = w; } }
    }
};


__device__ __forceinline__ float dpp_shr1(float oldv, float src) { return __int_as_float(__builtin_amdgcn_update_dpp(__float_as_int(oldv), __float_as_int(src), 0x111, 0xf, 0xf, false)); }
__device__ __forceinline__ float dpp_shr2(float oldv, float src) { return __int_as_float(__builtin_amdgcn_update_dpp(__float_as_int(oldv), __float_as_int(src), 0x112, 0xf, 0xf, false)); }
__device__ __forceinline__ float dpp_ror1(float src) { return __int_as_float(__builtin_amdgcn_update_dpp(0, __float_as_int(src), 0x121, 0xf, 0xf, false)); }
__device__ __forceinline__ float dpp_ror2(float src) { return __int_as_float(__builtin_amdgcn_update_dpp(0, __float_as_int(src), 0x122, 0xf, 0xf, false)); }
constexpr int UP_TPB = 17, UP_ROWS = 254, UP_SEQ = 4096, UP_DFF = 2816;
struct UpOrder : StaticOrder {
    __device__ __forceinline__ long arow(const Unit& u) const { const int b = u.pm / UP_TPB, i = u.pm - UP_TPB * b; return (long)b * UP_SEQ + UP_ROWS * i - 2; }
};
struct EpiGlu {
    static constexpr bool PERM = false, AFTER_DRAIN = false;
    bf16_t* ACT; const float* wfc; const float* bfc; PG8_LAS unsigned char* xb;
    __device__ __forceinline__ void operator()(const f32x4 (&acc)[2][2][4][2], const Unit& u, int wr, int wc, int fr, int fq) const {
        const int b = u.pm / UP_TPB, i = u.pm - UP_TPB * b, t0 = UP_ROWS * i - 2;
        PG8_LAS float* X = (PG8_LAS float*)xb;
        const int cc0 = 32 * wc + 4 * fq;
        if (fr >= 14) {
#pragma unroll
            for (int ai = 0; ai < 2; ++ai) { const int grp = 2 * ai + wr;
                if (grp < 3) {
#pragma unroll
                    for (int bj = 0; bj < 2; ++bj)
#pragma unroll
                        for (int n = 0; n < 2; ++n) *(PG8_LAS f32x4*)(X + (grp * 2 + (fr - 14)) * 256 + 128 * bj + 16 * n + cc0) = acc[ai][bj][3][n]; } }
        }
        asm volatile("s_waitcnt lgkmcnt(0)" ::: "memory"); __builtin_amdgcn_s_barrier(); asm volatile("" ::: "memory");
#pragma unroll
        for (int bj = 0; bj < 2; ++bj) {
            const int ch0 = 128 * u.pn + 32 * wc + 8 * fq + 4 * bj;
            f32x4 w0[2], w1[2], w2[2], bb[2];
#pragma unroll
            for (int n = 0; n < 2; ++n) { w0[n] = *(const f32x4*)(wfc + 0 * 2 * UP_DFF + n * UP_DFF + ch0); w1[n] = *(const f32x4*)(wfc + 1 * 2 * UP_DFF + n * UP_DFF + ch0);
                w2[n] = *(const f32x4*)(wfc + 2 * 2 * UP_DFF + n * UP_DFF + ch0); bb[n] = *(const f32x4*)(bfc + n * UP_DFF + ch0); }
#pragma unroll
            for (int ai = 0; ai < 2; ++ai) {
                const int grp = 2 * ai + wr;
                f32x4 prev[2], p1[2], p2[2];
#pragma unroll
                for (int n = 0; n < 2; ++n) {
                    if (grp > 0) { p1[n] = *(const PG8_LAS f32x4*)(X + ((grp - 1) * 2 + 1) * 256 + 128 * bj + 16 * n + cc0); p2[n] = *(const PG8_LAS f32x4*)(X + ((grp - 1) * 2 + 0) * 256 + 128 * bj + 16 * n + cc0); }
                    else { p1[n] = (f32x4){0.f, 0.f, 0.f, 0.f}; p2[n] = (f32x4){0.f, 0.f, 0.f, 0.f}; }
                    prev[n] = (f32x4){0.f, 0.f, 0.f, 0.f}; }
#pragma unroll
                for (int m = 0; m < 4; ++m) {
                    const int tr = 128 * ai + 64 * wr + 16 * m + fr, t = t0 + tr;
                    f32x4 y[2];
#pragma unroll
                    for (int n = 0; n < 2; ++n) {
                        f32x4 cur = acc[ai][bj][m][n];
                        if (i == 0 && tr < 2) cur = (f32x4){0.f, 0.f, 0.f, 0.f};
#pragma unroll
                        for (int e = 0; e < 4; ++e) {
                            float r1, r2;
                            if (m == 0) { r1 = p1[n][e]; r2 = fr == 0 ? p2[n][e] : p1[n][e]; }
                            else { r1 = dpp_ror1(prev[n][e]); r2 = dpp_ror2(prev[n][e]); }
                            const float s1 = dpp_shr1(r1, cur[e]), s2 = dpp_shr2(r2, cur[e]);
                            y[n][e] = w0[n][e] * s2 + w1[n][e] * s1 + w2[n][e] * cur[e] + bb[n][e];
                        }
                        prev[n] = cur;
                    }
                    float a[4];
#pragma unroll
                    for (int e = 0; e < 4; ++e) { const float gte = y[0][e]; a[e] = gte * __builtin_amdgcn_rcpf(1.f + __builtin_amdgcn_exp2f(-1.4426950408889634f * gte)) * y[1][e]; }
                    if (tr >= 2 && t < UP_SEQ) {
                        unsigned long long o = (unsigned long long)cvt_pk_bf16(a[0], a[1]) | ((unsigned long long)cvt_pk_bf16(a[2], a[3]) << 32);
                        *(unsigned long long*)(ACT + (size_t)(b * UP_SEQ + t) * UP_DFF + ch0) = o;
                    }
                }
            }
        }
    }
};

struct EpiResF32 {
    static constexpr bool PERM = false, AFTER_DRAIN = false;
    float* C; const float* R; int ldc;
    __device__ __forceinline__ void operator()(const f32x4 (&acc)[2][2][4][2], const Unit& u, int wr, int wc, int fr, int fq) const {
        const int row0 = u.pm * BM + wr * 64 + fr, col0 = u.pn * BM + wc * 32 + 4 * fq;
#pragma unroll
        for (int ai = 0; ai < 2; ++ai)
#pragma unroll
            for (int m = 0; m < 4; ++m) { const size_t off = (size_t)(row0 + ai * HALF + m * 16) * ldc + col0;
#pragma unroll
                for (int bj = 0; bj < 2; ++bj)
#pragma unroll
                    for (int n = 0; n < 2; ++n) { const f32x4 r = *(const f32x4*)(R + off + bj * HALF + n * 16); *(f32x4*)(C + off + bj * HALF + n * 16) = r + acc[ai][bj][m][n]; }
                asm volatile("" ::: "memory"); }
    }
};

template <class Epi, class Sched, bool ALIGN_EPI = false, bool SP2 = false>
__device__ __forceinline__ void gemm_phase(PG8_LAS unsigned char* lds, const Gemm g, const Sched& S, const Epi& E) {
    const int tid = threadIdx.x, wid = __builtin_amdgcn_readfirstlane(tid >> 6), lane = tid & 63, wr = wid >> 2, wc = wid & 3, fr = lane & 15, fq = lane >> 4;
    const int K = g.K, nt = K / BK;
    unsigned voffA[2], voffB[2];
#pragma unroll
    for (int i = 0; i < 2; ++i) { int R, C; stage_rc(tid * 16 + i * 8192, R, C); const int Rb = Epi::PERM ? ((R & ~31) + perm32(R & 31)) : R;
        voffA[i] = (unsigned)(R * K + C) * 2u; voffB[i] = (unsigned)(Rb * K + C) * 2u; }
    const size_t kstep = (size_t)(BK * 2);
    const size_t hstep = (size_t)HALF * K * 2;
    const size_t tstep = 2 * hstep;
    const unsigned ldsw = (unsigned)wid * 1024u;
    const int aoff = lds_byte(wr * 64 + fr, fq * 8), boff = lds_byte(wc * 32 + fr, fq * 8);
#define PG8_SA(b, h) (((b) * 2 + (h)) * HTB)
#define PG8_SB(b, h) ((4 + (b) * 2 + (h)) * HTB)
#define PG8_STAGE(bufoff, gbase, voff) do { _Pragma("unroll") for (int _i = 0; _i < 2; ++_i) \
        __builtin_amdgcn_global_load_lds((const unsigned*)((const char*)(gbase) + (voff)[_i]), (PG8_LAS unsigned*)(lds + (bufoff) + ldsw + _i * 8192), 16, 0, 0); } while (0)
#define PG8_LDA(dst, b, h) do { _Pragma("unroll") for (int m = 0; m < 4; ++m) _Pragma("unroll") for (int k = 0; k < 2; ++k) dst[m][k] = *(const PG8_LAS bf16x8*)(lds + PG8_SA(b, h) + aoff + m * 2048 + k * 1024); } while (0)
#define PG8_LDB(dst, b, h) do { _Pragma("unroll") for (int n = 0; n < 2; ++n) _Pragma("unroll") for (int k = 0; k < 2; ++k) dst[n][k] = *(const PG8_LAS bf16x8*)(lds + PG8_SB(b, h) + boff + n * 2048 + k * 1024); } while (0)
#define PG8_MMA(ai, bj, At, Bt) do { __builtin_amdgcn_s_setprio(1); _Pragma("unroll") for (int m = 0; m < 4; ++m) _Pragma("unroll") for (int n = 0; n < 2; ++n) _Pragma("unroll") for (int k = 0; k < 2; ++k) \
        acc[ai][bj][m][n] = __builtin_amdgcn_mfma_f32_16x16x32_bf16(Bt[n][k], At[m][k], acc[ai][bj][m][n], 0, 0, 0); __builtin_amdgcn_s_setprio(0); } while (0)
#define PG8_WAIT_V(n) asm volatile("s_waitcnt vmcnt(" #n ")" ::: "memory")
#define PG8_WAIT_L(n) asm volatile("s_waitcnt lgkmcnt(" #n ")" ::: "memory")
#define PG8_BAR __builtin_amdgcn_s_barrier()
#define PG8_SCHED __builtin_amdgcn_sched_barrier(0)
    Unit cur, nxt; int ui = 0;
    if (!S.next(0, cur)) return;
    f32x4 acc[2][2][4][2];
#pragma unroll
    for (int a = 0; a < 2; ++a)
#pragma unroll
        for (int b = 0; b < 2; ++b)
#pragma unroll
            for (int m = 0; m < 4; ++m)
#pragma unroll
                for (int n = 0; n < 2; ++n) acc[a][b][m][n] = (f32x4){0.f, 0.f, 0.f, 0.f};
    bf16x8 At[4][2], B0[2][2], B1[2][2];
    const size_t rstep = (size_t)K * 2;
    const char* cA = (const char*)g.A + S.arow(cur) * (long)rstep; const char* cB = (const char*)g.Bt + (size_t)cur.pn * tstep;
    S.a_ready(cur);
    if constexpr (SP2) {
        PG8_STAGE(PG8_SB(0, 0), cB, voffB); PG8_STAGE(PG8_SB(0, 1), cB + hstep, voffB); PG8_STAGE(PG8_SA(0, 0), cA, voffA); PG8_STAGE(PG8_SA(0, 1), cA + hstep, voffA);
        if (wr == 1) PG8_BAR;
        PG8_WAIT_V(2); PG8_BAR;
        PG8_STAGE(PG8_SB(1, 0), cB + kstep, voffB); PG8_STAGE(PG8_SA(1, 0), cA + kstep, voffA); PG8_STAGE(PG8_SB(1, 1), cB + hstep + kstep, voffB);
        PG8_WAIT_V(6); PG8_BAR;
    } else {
        PG8_STAGE(PG8_SB(0, 0), cB, voffB); PG8_STAGE(PG8_SA(0, 0), cA, voffA); PG8_STAGE(PG8_SB(0, 1), cB + hstep, voffB); PG8_STAGE(PG8_SA(0, 1), cA + hstep, voffA);
        if (wr == 1) PG8_BAR;
        PG8_WAIT_V(4); PG8_BAR;
        PG8_STAGE(PG8_SB(1, 0), cB + kstep, voffB); PG8_STAGE(PG8_SA(1, 0), cA + kstep, voffA); PG8_STAGE(PG8_SB(1, 1), cB + hstep + kstep, voffB);
        PG8_WAIT_V(6); PG8_BAR;
    }
    for (;;) {
        const bool has_next = S.next(ui + 1, nxt);
        const char* nA = has_next ? (const char*)g.A + S.arow(nxt) * (long)rstep : cA; const char* nB = has_next ? (const char*)g.Bt + (size_t)nxt.pn * tstep : cB;
        for (int t = 0; t < nt; t += 2) {
            const bool last = (t == nt - 2);
            const char* a1 = cA + (size_t)(t + 1) * kstep;
            const char* a2 = last ? nA : cA + (size_t)(t + 2) * kstep; const char* b2 = last ? nB : cB + (size_t)(t + 2) * kstep;
            const char* a3 = a2 + kstep; const char* b3 = b2 + kstep;
            if (last && has_next) S.a_ready(nxt);
            if constexpr (SP2) {
            PG8_LDB(B0, 0, 0); PG8_LDB(B1, 0, 1); PG8_SCHED; PG8_LDA(At, 0, 0); PG8_STAGE(PG8_SA(1, 1), a1 + hstep, voffA);
            PG8_WAIT_V(8); PG8_WAIT_L(0); PG8_BAR; PG8_MMA(0, 0, At, B0); PG8_MMA(0, 1, At, B1); PG8_BAR; PG8_SCHED;
            PG8_LDA(At, 0, 1); PG8_STAGE(PG8_SB(0, 0), b2, voffB); PG8_STAGE(PG8_SB(0, 1), b2 + hstep, voffB); PG8_STAGE(PG8_SA(0, 0), a2, voffA);
            PG8_WAIT_V(8); PG8_WAIT_L(0); PG8_BAR; PG8_MMA(1, 0, At, B0); PG8_MMA(1, 1, At, B1); PG8_BAR; PG8_SCHED;
            PG8_LDB(B0, 1, 0); PG8_LDB(B1, 1, 1); PG8_SCHED; PG8_LDA(At, 1, 0); PG8_STAGE(PG8_SA(0, 1), a2 + hstep, voffA);
            PG8_WAIT_V(8); PG8_WAIT_L(0); PG8_BAR; PG8_MMA(0, 0, At, B0); PG8_MMA(0, 1, At, B1); PG8_BAR; PG8_SCHED;
            PG8_LDA(At, 1, 1); PG8_STAGE(PG8_SB(1, 0), b3, voffB); PG8_STAGE(PG8_SB(1, 1), b3 + hstep, voffB); PG8_STAGE(PG8_SA(1, 0), a3, voffA);
            PG8_WAIT_V(8); PG8_WAIT_L(0); PG8_BAR; PG8_MMA(1, 0, At, B0); PG8_MMA(1, 1, At, B1); PG8_BAR; PG8_SCHED;
            } else {
            PG8_LDB(B0, 0, 0); PG8_SCHED; PG8_LDA(At, 0, 0); PG8_STAGE(PG8_SA(1, 1), a1 + hstep, voffA);
            PG8_WAIT_L(8); PG8_BAR; PG8_WAIT_L(0); PG8_MMA(0, 0, At, B0); PG8_BAR; PG8_SCHED;
            PG8_LDB(B1, 0, 1); PG8_STAGE(PG8_SB(0, 0), b2, voffB);
            PG8_BAR; PG8_WAIT_L(0); PG8_MMA(0, 1, At, B1); PG8_BAR;
            PG8_LDA(At, 0, 1); PG8_STAGE(PG8_SA(0, 0), a2, voffA);
            PG8_BAR; PG8_WAIT_L(0); PG8_MMA(1, 0, At, B0); PG8_BAR; PG8_SCHED;
            PG8_STAGE(PG8_SB(0, 1), b2 + hstep, voffB);
            PG8_WAIT_V(6); PG8_BAR; PG8_MMA(1, 1, At, B1); PG8_BAR;
            PG8_LDB(B0, 1, 0); PG8_SCHED; PG8_LDA(At, 1, 0); PG8_STAGE(PG8_SA(0, 1), a2 + hstep, voffA);
            PG8_WAIT_L(8); PG8_BAR; PG8_WAIT_L(0); PG8_MMA(0, 0, At, B0); PG8_BAR; PG8_SCHED;
            PG8_LDB(B1, 1, 1); PG8_STAGE(PG8_SB(1, 0), b3, voffB);
            PG8_BAR; PG8_WAIT_L(0); PG8_MMA(0, 1, At, B1); PG8_BAR;
            PG8_LDA(At, 1, 1); PG8_STAGE(PG8_SA(1, 0), a3, voffA);
            PG8_BAR; PG8_WAIT_L(0); PG8_MMA(1, 0, At, B0); PG8_BAR; PG8_SCHED;
            PG8_STAGE(PG8_SB(1, 1), b3 + hstep, voffB);
            PG8_WAIT_V(6); PG8_BAR; PG8_MMA(1, 1, At, B1); PG8_BAR;
            }
        }
        if constexpr (ALIGN_EPI) { if (wr == 0) PG8_BAR; }
        if constexpr (!Epi::AFTER_DRAIN) { E(acc, cur, wr, wc, fr, fq); S.done(cur); }
        if (!has_next) break;
#pragma unroll
        for (int a = 0; a < 2; ++a)
#pragma unroll
            for (int b = 0; b < 2; ++b)
#pragma unroll
                for (int m = 0; m < 4; ++m)
#pragma unroll
                    for (int n = 0; n < 2; ++n) acc[a][b][m][n] = (f32x4){0.f, 0.f, 0.f, 0.f};
        cur = nxt; cA = nA; cB = nB; ++ui;
        if constexpr (ALIGN_EPI) { if (wr == 1) PG8_BAR; }
    }
    PG8_WAIT_V(0);
    if constexpr (!ALIGN_EPI) { if (wr == 0) PG8_BAR; }
    PG8_BAR;
    if constexpr (Epi::AFTER_DRAIN) { E.fused(acc, cur, wr, wc, fr, fq, lds, wid, lane); S.done(cur); }
#undef PG8_SA
#undef PG8_SB
#undef PG8_STAGE
#undef PG8_LDA
#undef PG8_LDB
#undef PG8_MMA
#undef PG8_WAIT_V
#undef PG8_WAIT_L
#undef PG8_BAR
#undef PG8_SCHED
}
}


#define XB_TMO      128
#define XB_XCNT(j)  (256  + 64 * (j))
#define XB_XSUB(j)  (1280 + 64 * (j))
#define XB_XGEN(j)  (2304 + 64 * (j))
#define XB_TOP      3328
#define XB_TOPGEN   3392
#define XCD_BAR_WORDS 3456
#define XB_SPIN_CAP (1u << 18)
__device__ __forceinline__ unsigned xb_ld(unsigned* p)              { return __hip_atomic_load(p, __ATOMIC_RELAXED, __HIP_MEMORY_SCOPE_AGENT); }
__device__ __forceinline__ unsigned xb_add(unsigned* p, unsigned v) { return __hip_atomic_fetch_add(p, v, __ATOMIC_RELAXED, __HIP_MEMORY_SCOPE_AGENT); }
__device__ __forceinline__ unsigned xb_xcc_id() { return (unsigned)__builtin_amdgcn_s_getreg((3 << 11) | 20) & 0xFu; }
#define XB_SPIN(cond, bar) do { unsigned _sp = 0; while (cond) { __builtin_amdgcn_s_sleep(1); \
    if ((++_sp & 255u) == 0u) { if (xb_ld(&(bar)[XB_TMO])) break; if (_sp > XB_SPIN_CAP) { atomicAdd(&(bar)[XB_TMO], 1u); break; } } } } while (0)
struct XcdBarrier { unsigned* bar; unsigned x; volatile LAS unsigned* st; };
__device__ __forceinline__ XcdBarrier xcd_barrier_post(unsigned* bar, volatile LAS unsigned* st) {
    XcdBarrier b; b.bar = bar; b.x = xb_xcc_id(); b.st = st;
    if (threadIdx.x == 0) (void)xb_add(&bar[XB_XCNT(b.x)], 1u);
    return b;
}
__device__ __forceinline__ void xcd_barrier_complete(unsigned* bar, unsigned x, unsigned& nloc, unsigned& nx) {
    const unsigned G = gridDim.x * gridDim.y * gridDim.z;
    unsigned sum, cnt, mine, sp = 0u;
    for (;;) {
        sum = 0u; cnt = 0u; mine = 0u;
#pragma unroll
        for (unsigned j = 0; j < 16; ++j) { const unsigned c = xb_ld(&bar[XB_XCNT(j)]); sum += c; cnt += (c > 0u) ? 1u : 0u; mine = (j == x) ? c : mine; }
        if (sum == G) break;
        __builtin_amdgcn_s_sleep(1);
        if ((++sp & 255u) == 0u) { if (xb_ld(&bar[XB_TMO])) break; if (sp > XB_SPIN_CAP) { atomicAdd(&bar[XB_TMO], 1u); break; } }
    }
    nloc = mine > 0u ? mine : 1u; nx = cnt > 0u ? cnt : 1u;
}
__device__ __forceinline__ void xcd_barrier(const XcdBarrier& b) {
    asm volatile("s_waitcnt vmcnt(0)" ::: "memory");
    __syncthreads();
    if (threadIdx.x == 0) {
        unsigned* bar = b.bar;
        __builtin_amdgcn_s_waitcnt(0);
        unsigned nloc = b.st[0], nx = b.st[1];
        if (nloc == 0u) { xcd_barrier_complete(bar, b.x, nloc, nx); b.st[0] = nloc; b.st[1] = nx; }
        const unsigned old = xb_add(&bar[XB_XSUB(b.x)], 1u);
        const unsigned gen = old / nloc;
        if (old + 1u == (gen + 1u) * nloc) {
            __builtin_amdgcn_fence(__ATOMIC_RELEASE, "agent");
            asm volatile("s_waitcnt vmcnt(0)" ::: "memory");
            const unsigned og = xb_add(&bar[XB_TOP], 1u);
            const unsigned tg = og / nx;
            if (og + 1u == (tg + 1u) * nx) xb_add(&bar[XB_TOPGEN], 1u);
            else XB_SPIN(xb_ld(&bar[XB_TOPGEN]) == tg, bar);
            __builtin_amdgcn_fence(__ATOMIC_ACQUIRE, "agent");
            xb_add(&bar[XB_XGEN(b.x)], 1u);
            asm volatile("s_waitcnt vmcnt(0)" ::: "memory");
        } else {
            XB_SPIN(xb_ld(&bar[XB_XGEN(b.x)]) == gen, bar);
            __builtin_amdgcn_fence(__ATOMIC_ACQUIRE, "agent");
            asm volatile("s_waitcnt vmcnt(0)" ::: "memory");
        }
    }
    __syncthreads();
}


#define LDS_WAIT() asm volatile("s_waitcnt lgkmcnt(0)" ::: "memory")
__device__ __forceinline__ int up_rowmap(int n) { const int kind = n >= DFF ? 1 : 0, ch = n - kind * DFF, r = ch & 127; return 256 * (ch >> 7) + 128 * ((r & 7) >> 2) + 32 * (r >> 5) + 16 * kind + 4 * ((r & 31) >> 3) + (r & 3); }
template <bool UPMAP>
__device__ __forceinline__ void p0_transpose_item(const float* W, int K, int N, bf16* WT, LAS float* scr, int item, int lane) {
    const int nblk = N / 32, kb = item / nblk, nb = item % nblk, k0 = 64 * kb, n0 = 32 * nb;
#pragma unroll 8
    for (int i = 0; i < 32; ++i) { const int kk = 2 * i + (lane >> 5); scr[kk * 33 + (lane & 31)] = W[(size_t)(k0 + kk) * N + n0 + (lane & 31)]; }
    LDS_WAIT(); asm volatile("" ::: "memory");
    const int c = lane & 7;
#pragma unroll
    for (int j = 0; j < 4; ++j) { const int n = (lane >> 3) + 8 * j; const LAS float* s = scr + (8 * c) * 33 + n;
        u32x4 o; o.x = pk2(s[0 * 33], s[1 * 33]); o.y = pk2(s[2 * 33], s[3 * 33]); o.z = pk2(s[4 * 33], s[5 * 33]); o.w = pk2(s[6 * 33], s[7 * 33]);
        *(u32x4*)(WT + (size_t)(UPMAP ? up_rowmap(n0 + n) : (n0 + n)) * K + k0 + 8 * c) = o; }
    LDS_WAIT(); asm volatile("" ::: "memory");
}

constexpr int N_PHASES = 13;
__global__ void __launch_bounds__(NTHR, 2) fwd(Args args) {
    extern __shared__ __attribute__((aligned(16))) unsigned char lds[];
    const int tid = threadIdx.x, lane = tid & 63, wave = tid >> 6;
    const int gw = blockIdx.x * NWAVES + wave, ngw = gridDim.x * NWAVES;
    const int gtid = blockIdx.x * NTHR + tid, ngt = gridDim.x * NTHR;
    unsigned char* ws = args.ws;
    const float* x = args.in[0]; const float* mem = args.in[1]; const float* rel_bias = args.in[2]; const float* g_mix = args.in[3]; const float* w_in = args.in[4];
    const float* w_sc = args.in[5]; const float* g_ao = args.in[6]; const float* g_co = args.in[7]; const float* w_out = args.in[8]; const float* g_xa = args.in[9];
    const float* g_mem = args.in[10]; const float* w_xq = args.in[11]; const float* w_xk = args.in[12]; const float* w_xv = args.in[13]; const float* w_xo = args.in[14];
    const float* g_ffn = args.in[15]; const float* w_up = args.in[16]; const float* w_fc = args.in[17]; const float* b_fc = args.in[18]; const float* w_down = args.in[19];
    const float* g_fin = args.in[20];
    float* out = args.out;
    bf16* XN = (bf16*)(ws + WS_XN); bf16* PROJ = (bf16*)(ws + WS_PROJ); bf16* PART = (bf16*)(ws + WS_PART); float* STM = (float*)(ws + WS_STM); float* STL = (float*)(ws + WS_STL);
    bf16* MIX = (bf16*)(ws + WS_MIX); bf16* MEMN = (bf16*)(ws + WS_MEMN); bf16* K2 = (bf16*)(ws + WS_K2); bf16* V2 = (bf16*)(ws + WS_V2);
    bf16* Q2 = (bf16*)(ws + WS_Q2); bf16* O2 = (bf16*)(ws + WS_O2); bf16* ACT = (bf16*)(ws + WS_ACT);
    bf16* WIN = (bf16*)(ws + WS_WIN); bf16* WOUT = (bf16*)(ws + WS_WOUT); bf16* WXQ = (bf16*)(ws + WS_WXQ); bf16* WXK = (bf16*)(ws + WS_WXK); bf16* WXV = (bf16*)(ws + WS_WXV);
    bf16* WXO = (bf16*)(ws + WS_WXO); bf16* WUP = (bf16*)(ws + WS_WUP); bf16* WDN = (bf16*)(ws + WS_WDN);
    LAS unsigned char* ldsl = (LAS unsigned char*)lds;
    const int G = gridDim.x, bx = blockIdx.x;
    const int lo = args.ph_lo, hi = args.ph_hi;
    volatile LAS unsigned* MISC = (volatile LAS unsigned*)((LAS unsigned char*)lds + MISC_OFF);
    if (tid < 32) MISC[tid] = 0u;
    __syncthreads();
    XcdBarrier bar = xcd_barrier_post((unsigned*)(ws + WS_CTL) + 1024, MISC + 8);
#define SEAM(k) do { if (IN(k) && IN((k) + 1)) xcd_barrier(bar); } while (0)
#define IN(k) (lo <= (k) && (k) < hi)
    if (IN(0)) {
        LAS float* scr = (LAS float*)(ldsl + wave * 16384);
        constexpr int I_IN = (DM / 64) * (NPROJ / 32), I_SQ = (DM / 64) * (DM / 32), I_UP = (DM / 64) * (NUP / 32), I_DN = (DFF / 64) * (DM / 32);
        constexpr int NITEMS = I_IN + 5 * I_SQ + I_UP + I_DN;
        for (int it = gw; it < NITEMS; it += ngw) {
            int r = it;
            if (r < I_IN) { p0_transpose_item<false>(w_in, DM, NPROJ, WIN, scr, r, lane); continue; } r -= I_IN;
            if (r < I_SQ) { p0_transpose_item<false>(w_out, DM, DM, WOUT, scr, r, lane); continue; } r -= I_SQ;
            if (r < I_SQ) { p0_transpose_item<false>(w_xq, DM, DM, WXQ, scr, r, lane); continue; } r -= I_SQ;
            if (r < I_SQ) { p0_transpose_item<false>(w_xk, DM, DM, WXK, scr, r, lane); continue; } r -= I_SQ;
            if (r < I_SQ) { p0_transpose_item<false>(w_xv, DM, DM, WXV, scr, r, lane); continue; } r -= I_SQ;
            if (r < I_SQ) { p0_transpose_item<false>(w_xo, DM, DM, WXO, scr, r, lane); continue; } r -= I_SQ;
            if (r < I_UP) { p0_transpose_item<true>(w_up, DM, NUP, WUP, scr, r, lane); continue; } r -= I_UP;
            p0_transpose_item<false>(w_down, DFF, DM, WDN, scr, r, lane);
        }
        rms_rows_bf16(x, g_mix, XN, M, gw, ngw, lane); rms_rows_bf16(mem, g_mem, MEMN, MM, gw, ngw, lane);
    }
    SEAM(0);
    if (IN(1)) { pg8::Gemm g{XN, WIN, M, NPROJ, DM}; pg8::StaticOrder S; S.init(M, NPROJ, G, bx);
        pg8::EpiBf16<0> E{PROJ, 512, nullptr, 512, (size_t)M * 512, 0.125f * LOG2E};
        pg8::gemm_phase<pg8::EpiBf16<0>, pg8::StaticOrder, true, true>(ldsl, g, S, E); }
    SEAM(1);
    if (IN(2)) attn_dilated(PROJ, PROJ + (size_t)M * 512, PROJ + (size_t)2 * M * 512, rel_bias, PART, STM, STL, ldsl);
    SEAM(2);
    if (IN(3)) {
        const int nkv = (G >= 64) ? 32 : 0;
        if (bx < nkv || nkv == 0) { pg8::Gemm g{MEMN, WXK, MM, 2 * DM, DM}; pg8::StaticOrder S; S.init(MM, 2 * DM, nkv ? nkv : G, bx);
            pg8::EpiBf16<0> E{K2, DM, nullptr, DM, (size_t)MM * DM, 1.f};
            pg8::gemm_phase<pg8::EpiBf16<0>, pg8::StaticOrder, true, true>(ldsl, g, S, E); }
        if (bx >= nkv) mix_rows(PART, STM, STL, PROJ + (size_t)3 * M * 512, PROJ + (size_t)4 * M * 512, PROJ + (size_t)5 * M * 512, w_sc, g_ao, g_co, MIX, gw - nkv * NWAVES, ngw - nkv * NWAVES, lane);
    }
    SEAM(3);
    if (IN(4)) { pg8::Gemm g{MIX, WOUT, M, DM, DM}; pg8::StaticOrder S; S.init(M, DM, G, bx);
        pg8::EpiResF32 E{out, x, DM};
        pg8::gemm_phase<pg8::EpiResF32, pg8::StaticOrder, true, true>(ldsl, g, S, E); }
    SEAM(4);
    if (IN(5)) rms_rows_bf16(out, g_xa, XN, M, gw, ngw, lane);
    SEAM(5);
    if (IN(6)) { pg8::Gemm g{XN, WXQ, M, DM, DM}; pg8::StaticOrder S; S.init(M, DM, G, bx);
        pg8::EpiBf16<0> E{Q2, DM, nullptr, DM, 0, 0.0625f * LOG2E};
        pg8::gemm_phase<pg8::EpiBf16<0>, pg8::StaticOrder, true, true>(ldsl, g, S, E); }
    SEAM(6);
    if (IN(7)) attn_cross(Q2, K2, V2, O2, ldsl);
    SEAM(7);
    if (IN(8)) { pg8::Gemm g{O2, WXO, M, DM, DM}; pg8::StaticOrder S; S.init(M, DM, G, bx);
        pg8::EpiResF32 E{out, out, DM};
        pg8::gemm_phase<pg8::EpiResF32, pg8::StaticOrder, true, true>(ldsl, g, S, E); }
    SEAM(8);
    if (IN(9)) rms_rows_bf16(out, g_ffn, XN, M, gw, ngw, lane);
    SEAM(9);
    if (IN(10)) { pg8::Gemm g{XN, WUP, 68 * 256, NUP, DM}; pg8::UpOrder S; S.init(68 * 256, NUP, G, bx);
        pg8::EpiGlu E{ACT, w_fc, b_fc, ldsl + XB_OFF};
        pg8::gemm_phase<pg8::EpiGlu, pg8::UpOrder, true, true>(ldsl, g, S, E); }
    SEAM(10);
    if (IN(11)) { pg8::Gemm g{ACT, WDN, M, DM, DFF}; pg8::StaticOrder S; S.init(M, DM, G, bx);
        pg8::EpiResF32 E{out, out, DM};
        pg8::gemm_phase<pg8::EpiResF32, pg8::StaticOrder, true, true>(ldsl, g, S, E); }
    SEAM(11);
    if (IN(12)) rms_rows_f32_inplace(out, g_fin, M, gw, ngw, lane);
#undef IN
#undef SEAM
}

extern "C" void kernel_launch(void* const* d_in, const int* in_sizes, int n_in, void* d_out, int out_size, void* d_ws, size_t ws_size, hipStream_t stream) {
    static int grid = 0;
    if (grid == 0) {
        if (n_in != 21 || out_size != M * DM || ws_size < 256 * MiB) { fprintf(stderr, "kernel_launch: unexpected shapes (n_in %d out %d ws %zu)\n", n_in, out_size, ws_size); grid = -1; return; }
        int dev = 0, cus = 0;
        (void)hipGetDevice(&dev); (void)hipDeviceGetAttribute(&cus, hipDeviceAttributeMultiprocessorCount, dev);
        if (hipFuncSetAttribute((const void*)fwd, hipFuncAttributeMaxDynamicSharedMemorySize, LDS_BYTES) != hipSuccess) { fprintf(stderr, "kernel_launch: hipFuncSetAttribute failed\n"); grid = -1; return; }
        int per_cu = 0;
        if (hipOccupancyMaxActiveBlocksPerMultiprocessor(&per_cu, (const void*)fwd, NTHR, LDS_BYTES) != hipSuccess || per_cu < 1) { fprintf(stderr, "kernel_launch: occupancy query says %d blocks/CU\n", per_cu); (void)hipGetLastError(); grid = -1; return; }
        grid = (cus > 0 ? cus : 256);
    }
    if (grid < 0) return;
    Args a{};
    for (int i = 0; i < 21; ++i) a.in[i] = (const float*)d_in[i];
    a.out = (float*)d_out; a.ws = (unsigned char*)d_ws;
    if (hipMemsetAsync((char*)d_ws + WS_CTL, 0, CTL_BYTES, stream) != hipSuccess) { fprintf(stderr, "kernel_launch: memset failed\n"); return; }
    a.ph_lo = 0; a.ph_hi = N_PHASES;
    hipLaunchKernelGGL(fwd, dim3(grid), dim3(NTHR), LDS_BYTES, stream, a);
}
```
